# Optimizing an MI355X kernel written in HIP

```python
import jax
import jax.numpy as jnp
from jax import lax
import numpy as np

D_MODEL = 1024
BATCH = 8
SEQ = 4096
DEPTH = 4

N_EVEN = (DEPTH + 1) // 2
N_ODD = DEPTH // 2
D_FF = 4 * D_MODEL
RMS_EPS = 1e-6
NEG_BIG = -1e30
F_MIN = 1e-30
A_WIDTH = D_MODEL // 2
A_HEAD_DIM = 128
A_HEADS = A_WIDTH // A_HEAD_DIM
A_CHUNK = 64
B_WIDTH = D_MODEL // 2
B_BLOCKS = 8
B_BLOCK_DIM = B_WIDTH // B_BLOCKS
B_CONV = 4
RG_C = 8.0
C_HEAD_DIM = 64
C_HEADS = D_MODEL // C_HEAD_DIM
C_KV_HEADS = 4
C_GROUP = C_HEADS // C_KV_HEADS
WINDOW = 128
ROPE_THETA = 10000.0
EVEN_IN = 4 * A_WIDTH + 2 * B_WIDTH
EVEN_SPLITS = (A_WIDTH, 2 * A_WIDTH, 3 * A_WIDTH, 4 * A_WIDTH, 4 * A_WIDTH + B_WIDTH)
ODD_IN = (C_HEADS + 2 * C_KV_HEADS) * C_HEAD_DIM
ODD_SPLITS = (C_HEADS * C_HEAD_DIM, (C_HEADS + C_KV_HEADS) * C_HEAD_DIM)

kernel_name = 'hybrid_hgrn2_rglru_swa_sinks_trunk'


def _rmsnorm(x, gain):
    xf = x.astype(jnp.float32)
    y = xf * lax.rsqrt(jnp.mean(xf * xf, axis=-1, keepdims=True) + RMS_EPS)
    return (y * gain.astype(jnp.float32)).astype(x.dtype)


def _headnorm(x, gain):
    xf = x.astype(jnp.float32)
    y = xf * lax.rsqrt(jnp.mean(xf * xf, axis=-1, keepdims=True) + RMS_EPS)
    return y * gain.astype(jnp.float32)


def _hgrn2(q, fx, v, lb):
    bsz, s = q.shape[0], q.shape[1]
    lb = lb.astype(jnp.float32)
    fx = fx.astype(jnp.float32)
    f = lb + (1.0 - lb) * jax.nn.sigmoid(fx)
    log_f = jnp.log(jnp.maximum(f, F_MIN))
    k = (1.0 - lb) * jax.nn.sigmoid(-fx)
    nc = s // A_CHUNK

    def to_chunks(t):
        return t.astype(jnp.float32).reshape(bsz, nc, A_CHUNK, A_HEADS, A_HEAD_DIM).transpose(1, 0, 3, 2, 4)

    causal = jnp.tril(jnp.ones((A_CHUNK, A_CHUNK), dtype=bool))[:, :, None]

    def step(state, inp):
        qc, kc, gc, vc = inp
        b = jnp.cumsum(gc, axis=2)
        o_inter = jnp.einsum('bhtd,bhde->bhte', qc * jnp.exp(b), state)
        diff = b[:, :, :, None, :] - b[:, :, None, :, :]
        decay = jnp.exp(jnp.where(causal, diff, NEG_BIG))
        scores = jnp.einsum('bhtsd,bhsd->bhts', qc[:, :, :, None, :] * decay, kc)
        o = o_inter + jnp.einsum('bhts,bhse->bhte', scores, vc)
        b_last = b[:, :, -1, :]
        state = jnp.exp(b_last)[..., None] * state + jnp.einsum(
            'bhsd,bhse->bhde', kc * jnp.exp(b_last[:, :, None, :] - b), vc)
        return state, o

    s0 = jnp.zeros((bsz, A_HEADS, A_HEAD_DIM, A_HEAD_DIM), jnp.float32)
    _, o = lax.scan(step, s0, (to_chunks(q), to_chunks(k), to_chunks(log_f), to_chunks(v)))
    return o.transpose(1, 0, 3, 2, 4).reshape(bsz, s, A_HEADS, A_HEAD_DIM)


def _rglru(xb, conv_w, conv_b, wa, ba, wx, bx, lam):
    bsz, s, _ = xb.shape
    xc = lax.conv_general_dilated(
        xb, conv_w[:, None, :].astype(xb.dtype), window_strides=(1,),
        padding=[(B_CONV - 1, 0)], dimension_numbers=('NWC', 'WIO', 'NWC'),
        feature_group_count=B_WIDTH) + conv_b.astype(xb.dtype)
    xf = xc.astype(jnp.float32)
    xblk = xf.reshape(bsz, s, B_BLOCKS, B_BLOCK_DIM)
    r = jax.nn.sigmoid(jnp.einsum('bsni,nij->bsnj', xblk, wa.astype(jnp.float32)).reshape(bsz, s, B_WIDTH)
                       + ba.astype(jnp.float32))
    i = jax.nn.sigmoid(jnp.einsum('bsni,nij->bsnj', xblk, wx.astype(jnp.float32)).reshape(bsz, s, B_WIDTH)
                       + bx.astype(jnp.float32))
    log_a = -RG_C * jax.nn.softplus(-lam.astype(jnp.float32)) * r
    a = jnp.exp(log_a)
    u = jnp.sqrt(jnp.maximum(-jnp.expm1(2.0 * log_a), 0.0)) * (i * xf)

    def combine(left, right):
        a1, u1 = left
        a2, u2 = right
        return a1 * a2, a2 * u1 + u2

    _, h = lax.associative_scan(combine, (a, u), axis=1)
    return h


def _rope(x, cos, sin):
    x1, x2 = jnp.split(x, 2, axis=-1)
    return jnp.concatenate([x1 * cos - x2 * sin, x2 * cos + x1 * sin], axis=-1)


def _swa_sinks(q, k, v, sinks):
    bsz, s = q.shape[0], q.shape[1]
    nb = s // WINDOW
    qb = q.reshape(bsz, nb, WINDOW, C_KV_HEADS, C_GROUP, C_HEAD_DIM)

    def band(t):
        tb = t.reshape(bsz, nb, WINDOW, C_KV_HEADS, C_HEAD_DIM)
        prev = jnp.pad(tb[:, :-1], ((0, 0), (1, 0), (0, 0), (0, 0), (0, 0)))
        return jnp.concatenate([prev, tb], axis=2)

    kb, vb = band(k), band(v)
    scores = jnp.einsum('bnqhgd,bnkhd->bnhgqk', qb, kb) * (C_HEAD_DIM ** -0.5)
    qi = jnp.arange(WINDOW)[:, None]
    ki = jnp.arange(2 * WINDOW)[None, :]
    rel = qi + WINDOW - ki
    in_band = (rel >= 0) & (rel < WINDOW)
    valid = (jnp.arange(nb) > 0)[:, None, None] | (ki >= WINDOW)[None]
    mask = in_band[None] & valid
    scores = jnp.where(mask[None, :, None, None], scores, NEG_BIG)
    sink = sinks.astype(jnp.float32).reshape(1, 1, C_KV_HEADS, C_GROUP, 1, 1)
    m = jnp.maximum(jnp.max(scores, axis=-1, keepdims=True), sink)
    p = jnp.exp(scores - m)
    denom = jnp.sum(p, axis=-1, keepdims=True) + jnp.exp(sink - m)
    out = jnp.einsum('bnhgqk,bnkhd->bnqhgd', p / denom, vb)
    return out.reshape(bsz, s, C_HEADS * C_HEAD_DIM)


def setup_inputs(seed: int = 0) -> dict:
    key = jax.random.key(seed)
    ks = jax.random.split(key, 24)
    f32 = jnp.float32

    def w(k, shape, fan_in):
        return jax.random.normal(k, shape, f32) * (fan_in ** -0.5)

    def gain(k, shape):
        return 1.0 + 0.02 * jax.random.normal(k, shape, f32)

    def bias(k, shape):
        return 0.01 * jax.random.normal(k, shape, f32)

    x = jax.random.normal(ks[0], (BATCH, SEQ, D_MODEL), f32)
    offsets = jax.random.randint(ks[1], (BATCH, 1), 0, 4096, dtype=jnp.int32)
    positions = offsets + jnp.arange(SEQ, dtype=jnp.int32)[None, :]
    a_init = jax.random.uniform(ks[17], (N_EVEN, B_WIDTH), f32, minval=0.9, maxval=0.999)
    return {
        'x': x,
        'positions': positions,
        'norm_mix': gain(ks[2], (DEPTH, D_MODEL)),
        'norm_mlp': gain(ks[3], (DEPTH, D_MODEL)),
        'w_mlp_in': w(ks[4], (DEPTH, D_MODEL, D_FF), D_MODEL),
        'w_mlp_out': w(ks[5], (DEPTH, D_FF, D_MODEL), D_FF),
        'w_in_even': w(ks[6], (N_EVEN, D_MODEL, EVEN_IN), D_MODEL),
        'w_out_even': w(ks[7], (N_EVEN, A_WIDTH + B_WIDTH, D_MODEL), A_WIDTH + B_WIDTH),
        'hgrn_lb_logits': 0.1 * jax.random.normal(ks[8], (N_EVEN, A_WIDTH), f32),
        'hgrn_out_norm': gain(ks[9], (N_EVEN, A_WIDTH)),
        'conv_w': w(ks[10], (N_EVEN, B_CONV, B_WIDTH), B_CONV),
        'conv_b': bias(ks[11], (N_EVEN, B_WIDTH)),
        'rg_wa': w(ks[12], (N_EVEN, B_BLOCKS, B_BLOCK_DIM, B_BLOCK_DIM), B_BLOCK_DIM),
        'rg_ba': bias(ks[13], (N_EVEN, B_WIDTH)),
        'rg_wx': w(ks[14], (N_EVEN, B_BLOCKS, B_BLOCK_DIM, B_BLOCK_DIM), B_BLOCK_DIM),
        'rg_bx': bias(ks[15], (N_EVEN, B_WIDTH)),
        'rg_lambda': jnp.log(a_init) - jnp.log1p(-a_init),
        'w_in_odd': w(ks[16], (N_ODD, D_MODEL, ODD_IN), D_MODEL),
        'w_out_odd': w(ks[18], (N_ODD, C_HEADS * C_HEAD_DIM, D_MODEL), C_HEADS * C_HEAD_DIM),
        'q_norm': gain(ks[19], (N_ODD, C_HEAD_DIM)),
        'k_norm': gain(ks[20], (N_ODD, C_HEAD_DIM)),
        'sinks': 0.5 * jax.random.normal(ks[21], (N_ODD, C_HEADS), f32),
    }


def reference(x, positions, norm_mix, norm_mlp, w_mlp_in, w_mlp_out, w_in_even, w_out_even,
              hgrn_lb_logits, hgrn_out_norm, conv_w, conv_b, rg_wa, rg_ba, rg_wx, rg_bx, rg_lambda,
              w_in_odd, w_out_odd, q_norm, k_norm, sinks):
    bsz, s, _ = x.shape
    sm = jax.nn.softmax(hgrn_lb_logits.astype(jnp.float32), axis=0)
    lower_bounds = jnp.cumsum(sm, axis=0) - sm[0]
    inv_freq = ROPE_THETA ** (-jnp.arange(0, C_HEAD_DIM, 2, dtype=jnp.float32) / C_HEAD_DIM)
    ang = positions.astype(jnp.float32)[..., None] * inv_freq
    cos = jnp.cos(ang)[:, :, None, :]
    sin = jnp.sin(ang)[:, :, None, :]

    for layer in range(DEPTH):
        h = _rmsnorm(x, norm_mix[layer])
        if layer % 2 == 0:
            e = layer // 2
            z = h @ w_in_even[e]
            qa, fa, va, ga, gate_b, xb = jnp.split(z, EVEN_SPLITS, axis=-1)
            heads = lambda t: t.reshape(bsz, s, A_HEADS, A_HEAD_DIM)
            oa = _hgrn2(heads(qa), heads(fa), heads(va), lower_bounds[e].reshape(A_HEADS, A_HEAD_DIM))
            oa = _headnorm(oa, hgrn_out_norm[e].reshape(A_HEADS, A_HEAD_DIM)).reshape(bsz, s, A_WIDTH)
            ya = (oa * jax.nn.silu(ga.astype(jnp.float32))).astype(x.dtype)
            hb = _rglru(xb, conv_w[e], conv_b[e], rg_wa[e], rg_ba[e], rg_wx[e], rg_bx[e], rg_lambda[e])
            yb = (hb * jax.nn.gelu(gate_b.astype(jnp.float32))).astype(x.dtype)
            mix = jnp.concatenate([ya, yb], axis=-1) @ w_out_even[e]
        else:
            o = layer // 2
            z = h @ w_in_odd[o]
            q, k, v = jnp.split(z, ODD_SPLITS, axis=-1)
            q = _rope(_headnorm(q.reshape(bsz, s, C_HEADS, C_HEAD_DIM), q_norm[o]), cos, sin)
            k = _rope(_headnorm(k.reshape(bsz, s, C_KV_HEADS, C_HEAD_DIM), k_norm[o]), cos, sin)
            v = v.reshape(bsz, s, C_KV_HEADS, C_HEAD_DIM).astype(jnp.float32)
            attn = _swa_sinks(q, k, v, sinks[o])
            mix = attn.astype(x.dtype) @ w_out_odd[o]
        x = x + mix
        h = _rmsnorm(x, norm_mlp[layer])
        x = x + jnp.square(jax.nn.relu(h @ w_mlp_in[layer])) @ w_mlp_out[layer]
    return x
```

```cpp
#include <hip/hip_runtime.h>
#include <hip/hip_cooperative_groups.h>
#include <cstdio>
#include <cstdint>
namespace cg = cooperative_groups;
namespace pg8 {
#define PG8_LAS __attribute__((address_space(3)))
typedef unsigned short bf16_t;
typedef short bf16x8 __attribute__((ext_vector_type(8)));
typedef float f32x4 __attribute__((ext_vector_type(4)));
typedef unsigned u32x4 __attribute__((ext_vector_type(4)));
constexpr int BM = 256, BK = 64, HALF = 128, HTB = HALF * BK * 2  , STAGE_BYTES = 8 * HTB, NXCD = 8, WGM = 8;

__host__ __device__ __forceinline__ int lds_byte(int r, int c) { const int st = (r >> 4) * 2 + (c >> 5), rr = r & 15, cc = c & 31, ob = rr * 64 + cc * 2; return st * 1024 + (ob ^ (((ob >> 9) & 1) << 5)); }
__host__ __device__ __forceinline__ void stage_rc(int b, int& R, int& C) { const int st = b / 1024, sb = b % 1024, swz = sb ^ (((sb >> 9) & 1) << 5); R = (st >> 1) * 16 + swz / 64; C = (st & 1) * 32 + (swz % 64) / 2; }
__host__ __device__ __forceinline__ int perm32(int rho) { const int n = rho >> 4, i = rho & 15; return 8 * (i >> 2) + 4 * n + (i & 3); }

struct Unit { int pm, pn; };
struct Gemm { const bf16_t* A; const bf16_t* Bt; int M, N, K; };

struct StaticOrder {
    int nM, nN, nwg, G, c;
    __host__ __device__ void init(int M, int N, int G_, int c_) { nM = M / BM; nN = N / BM; nwg = nM * nN; G = G_; c = c_; }
    __host__ __device__ bool next(int i, Unit& u) const {
        const long L = (long)i * G + c; if (L >= nwg) return false;
        int wgid = (int)L; { const int q = nwg / NXCD, r = nwg % NXCD, xcd = wgid % NXCD, off = wgid / NXCD; wgid = (xcd < r ? xcd * (q + 1) : r * (q + 1) + (xcd - r) * q) + off; }
        const int nig = WGM * nN, gid = wgid / nig, fm = gid * WGM, gsz = (nM - fm) < WGM ? (nM - fm) : WGM;
        u.pm = fm + ((wgid % nig) % gsz); u.pn = (wgid % nig) / gsz; return true;
    }
    __device__ __forceinline__ void a_ready(const Unit&) const {}
    __device__ __forceinline__ void done(const Unit&) const {}
};
__device__ __forceinline__ unsigned cvt_pk_bf16(float lo, float hi) { unsigned r; asm volatile("v_cvt_pk_bf16_f32 %0, %1, %2" : "=v"(r) : "v"(lo), "v"(hi)); return r; }
template <int ACT> struct EpiScaleBf16 {
    static constexpr bool PERM = true, AFTER_DRAIN = false;
    bf16_t* O; int ldc; const float* rowsq;
    __device__ __forceinline__ void operator()(const f32x4 (&acc)[2][2][4][2], const Unit& u, int wr, int wc, int fr, int fq) const {
        const int row0 = u.pm * BM + wr * 64 + fr; const int col0 = u.pn * BM + wc * 32 + 8 * fq;
#pragma unroll
        for (int ai = 0; ai < 2; ++ai)
#pragma unroll
            for (int m = 0; m < 4; ++m) { const int row = row0 + ai * HALF + m * 16; const f32x4* rp = (const f32x4*)(rowsq + (size_t)row * 16); const f32x4 p0 = rp[0], p1 = rp[1], p2 = rp[2], p3 = rp[3];
                const float tot = (((p0[0] + p0[1]) + (p0[2] + p0[3])) + ((p1[0] + p1[1]) + (p1[2] + p1[3]))) + (((p2[0] + p2[1]) + (p2[2] + p2[3])) + ((p3[0] + p3[1]) + (p3[2] + p3[3])));
                const float s = rsqrtf(tot * (1.0f / 1024.0f) + 1e-6f);
                bf16_t* rowp = O + (size_t)row * ldc + col0;
#pragma unroll
                for (int bj = 0; bj < 2; ++bj) { f32x4 v0 = acc[ai][bj][m][0] * s, v1 = acc[ai][bj][m][1] * s;
                    if (ACT == 1) {
#pragma unroll
                        for (int q = 0; q < 4; ++q) { const float a = fmaxf(v0[q], 0.f), b = fmaxf(v1[q], 0.f); v0[q] = a * a; v1[q] = b * b; } }
                    u32x4 w; w.x = cvt_pk_bf16(v0[0], v0[1]); w.y = cvt_pk_bf16(v0[2], v0[3]); w.z = cvt_pk_bf16(v1[0], v1[1]); w.w = cvt_pk_bf16(v1[2], v1[3]);
                    *(u32x4*)(rowp + bj * HALF) = w; } }
    }
};
struct EpiResid {
    static constexpr bool PERM = false, AFTER_DRAIN = false;
    const float* base; float* out; bf16_t* xb; float* rowsq_next; int ldc;
    __device__ __forceinline__ void operator()(const f32x4 (&acc)[2][2][4][2], const Unit& u, int wr, int wc, int fr, int fq) const {
        typedef unsigned u32x2v __attribute__((ext_vector_type(2)));
        const int row0 = u.pm * BM + wr * 64 + fr; const int col0 = u.pn * BM + wc * 32 + 4 * fq;
#pragma unroll
        for (int ai = 0; ai < 2; ++ai)
#pragma unroll
            for (int m = 0; m < 4; ++m) { const int row = row0 + ai * HALF + m * 16; const size_t off = (size_t)row * ldc + col0; float ss = 0.f;
#pragma unroll
                for (int bj = 0; bj < 2; ++bj)
#pragma unroll
                    for (int n = 0; n < 2; ++n) { const f32x4 bs = *(const f32x4*)(base + off + bj * HALF + n * 16); const f32x4 o = bs + acc[ai][bj][m][n];
                        *(f32x4*)(out + off + bj * HALF + n * 16) = o; ss += (o[0] * o[0] + o[1] * o[1]) + (o[2] * o[2] + o[3] * o[3]);
                        u32x2v w; w.x = cvt_pk_bf16(o[0], o[1]); w.y = cvt_pk_bf16(o[2], o[3]); *(u32x2v*)(xb + off + bj * HALF + n * 16) = w; }
                ss += __shfl_xor(ss, 16); ss += __shfl_xor(ss, 32);
                if (rowsq_next != nullptr && fq == 0) rowsq_next[(size_t)row * 16 + u.pn * 4 + wc] = ss; }
    }
};
template <class Epi, class Sched, bool ALIGN_EPI = false, bool SP2 = false>
__device__ __forceinline__ void gemm_phase(PG8_LAS unsigned char* lds, const Gemm g, const Sched& S, const Epi& E) {
    int tid_ = threadIdx.x; asm volatile("" : "+v"(tid_));
    const int tid = tid_, wid = __builtin_amdgcn_readfirstlane(tid >> 6), lane = tid & 63, wr = wid >> 2, wc = wid & 3, fr = lane & 15, fq = lane >> 4;
    const int K = g.K, nt = K / BK;
    unsigned voffA[2], voffB[2];
#pragma unroll
    for (int i = 0; i < 2; ++i) { int R, C; stage_rc(tid * 16 + i * 8192, R, C); const int Rb = Epi::PERM ? ((R & ~31) + perm32(R & 31)) : R;
        voffA[i] = (unsigned)(R * K + C) * 2u; voffB[i] = (unsigned)(Rb * K + C) * 2u; }
    const size_t kstep = (size_t)(BK * 2);
    const size_t hstep = (size_t)HALF * K * 2;
    const size_t tstep = 2 * hstep;
    const unsigned ldsw = (unsigned)wid * 1024u;
    const int aoff = lds_byte(wr * 64 + fr, fq * 8), boff = lds_byte(wc * 32 + fr, fq * 8);
#define PG8_SA(b, h) (((b) * 2 + (h)) * HTB)
#define PG8_SB(b, h) ((4 + (b) * 2 + (h)) * HTB)
#define PG8_STAGE(bufoff, gbase, voff) do { _Pragma("unroll") for (int _i = 0; _i < 2; ++_i) \
        __builtin_amdgcn_global_load_lds((const unsigned*)((const char*)(gbase) + (voff)[_i]), (PG8_LAS unsigned*)(lds + (bufoff) + ldsw + _i * 8192), 16, 0, 0); } while (0)
#define PG8_LDA(dst, b, h) do { _Pragma("unroll") for (int m = 0; m < 4; ++m) _Pragma("unroll") for (int k = 0; k < 2; ++k) dst[m][k] = *(const PG8_LAS bf16x8*)(lds + PG8_SA(b, h) + aoff + m * 2048 + k * 1024); } while (0)
#define PG8_LDB(dst, b, h) do { _Pragma("unroll") for (int n = 0; n < 2; ++n) _Pragma("unroll") for (int k = 0; k < 2; ++k) dst[n][k] = *(const PG8_LAS bf16x8*)(lds + PG8_SB(b, h) + boff + n * 2048 + k * 1024); } while (0)
#define PG8_MMA(ai, bj, At, Bt) do { __builtin_amdgcn_s_setprio(1); _Pragma("unroll") for (int m = 0; m < 4; ++m) _Pragma("unroll") for (int n = 0; n < 2; ++n) _Pragma("unroll") for (int k = 0; k < 2; ++k) \
        acc[ai][bj][m][n] = __builtin_amdgcn_mfma_f32_16x16x32_bf16(Bt[n][k], At[m][k], acc[ai][bj][m][n], 0, 0, 0); __builtin_amdgcn_s_setprio(0); } while (0)
#define PG8_WAIT_V(n) asm volatile("s_waitcnt vmcnt(" #n ")" ::: "memory")
#define PG8_WAIT_L(n) asm volatile("s_waitcnt lgkmcnt(" #n ")" ::: "memory")
#define PG8_BAR __builtin_amdgcn_s_barrier()
#define PG8_SCHED __builtin_amdgcn_sched_barrier(0)
    Unit cur, nxt; int ui = 0;
    if (!S.next(0, cur)) return;
    f32x4 acc[2][2][4][2];
#pragma unroll
    for (int a = 0; a < 2; ++a)
#pragma unroll
        for (int b = 0; b < 2; ++b)
#pragma unroll
            for (int m = 0; m < 4; ++m)
#pragma unroll
                for (int n = 0; n < 2; ++n) acc[a][b][m][n] = (f32x4){0.f, 0.f, 0.f, 0.f};
    bf16x8 At[4][2], B0[2][2], B1[2][2];
    const char* cA = (const char*)g.A + (size_t)cur.pm * tstep; const char* cB = (const char*)g.Bt + (size_t)cur.pn * tstep;
    S.a_ready(cur);
    if constexpr (SP2) {
        PG8_STAGE(PG8_SB(0, 0), cB, voffB); PG8_STAGE(PG8_SB(0, 1), cB + hstep, voffB); PG8_STAGE(PG8_SA(0, 0), cA, voffA); PG8_STAGE(PG8_SA(0, 1), cA + hstep, voffA);
        if (wr == 1) PG8_BAR;
        PG8_WAIT_V(2); PG8_BAR;
        PG8_STAGE(PG8_SB(1, 0), cB + kstep, voffB); PG8_STAGE(PG8_SA(1, 0), cA + kstep, voffA); PG8_STAGE(PG8_SB(1, 1), cB + hstep + kstep, voffB);
        PG8_WAIT_V(6); PG8_BAR;
    } else {
        PG8_STAGE(PG8_SB(0, 0), cB, voffB); PG8_STAGE(PG8_SA(0, 0), cA, voffA); PG8_STAGE(PG8_SB(0, 1), cB + hstep, voffB); PG8_STAGE(PG8_SA(0, 1), cA + hstep, voffA);
        if (wr == 1) PG8_BAR;
        PG8_WAIT_V(4); PG8_BAR;
        PG8_STAGE(PG8_SB(1, 0), cB + kstep, voffB); PG8_STAGE(PG8_SA(1, 0), cA + kstep, voffA); PG8_STAGE(PG8_SB(1, 1), cB + hstep + kstep, voffB);
        PG8_WAIT_V(6); PG8_BAR;
    }
    for (;;) {
        const bool has_next = S.next(ui + 1, nxt);
        const char* nA = has_next ? (const char*)g.A + (size_t)nxt.pm * tstep : cA; const char* nB = has_next ? (const char*)g.Bt + (size_t)nxt.pn * tstep : cB;
        for (int t = 0; t < nt; t += 2) {
            const bool last = (t == nt - 2);
            const char* a1 = cA + (size_t)(t + 1) * kstep;
            const char* a2 = last ? nA : cA + (size_t)(t + 2) * kstep; const char* b2 = last ? nB : cB + (size_t)(t + 2) * kstep;
            const char* a3 = a2 + kstep; const char* b3 = b2 + kstep;
            if (last && has_next) S.a_ready(nxt);
            if constexpr (SP2) {
            PG8_LDB(B0, 0, 0); PG8_LDB(B1, 0, 1); PG8_SCHED; PG8_LDA(At, 0, 0); PG8_STAGE(PG8_SA(1, 1), a1 + hstep, voffA);
            PG8_WAIT_V(8); PG8_WAIT_L(0); PG8_BAR; PG8_MMA(0, 0, At, B0); PG8_MMA(0, 1, At, B1); PG8_BAR; PG8_SCHED;
            PG8_LDA(At, 0, 1); PG8_STAGE(PG8_SB(0, 0), b2, voffB); PG8_STAGE(PG8_SB(0, 1), b2 + hstep, voffB); PG8_STAGE(PG8_SA(0, 0), a2, voffA);
            PG8_WAIT_V(8); PG8_WAIT_L(0); PG8_BAR; PG8_MMA(1, 0, At, B0); PG8_MMA(1, 1, At, B1); PG8_BAR; PG8_SCHED;
            PG8_LDB(B0, 1, 0); PG8_LDB(B1, 1, 1); PG8_SCHED; PG8_LDA(At, 1, 0); PG8_STAGE(PG8_SA(0, 1), a2 + hstep, voffA);
            PG8_WAIT_V(8); PG8_WAIT_L(0); PG8_BAR; PG8_MMA(0, 0, At, B0); PG8_MMA(0, 1, At, B1); PG8_BAR; PG8_SCHED;
            PG8_LDA(At, 1, 1); PG8_STAGE(PG8_SB(1, 0), b3, voffB); PG8_STAGE(PG8_SB(1, 1), b3 + hstep, voffB); PG8_STAGE(PG8_SA(1, 0), a3, voffA);
            PG8_WAIT_V(8); PG8_WAIT_L(0); PG8_BAR; PG8_MMA(1, 0, At, B0); PG8_MMA(1, 1, At, B1); PG8_BAR; PG8_SCHED;
            } else {
            PG8_LDB(B0, 0, 0); PG8_SCHED; PG8_LDA(At, 0, 0); PG8_STAGE(PG8_SA(1, 1), a1 + hstep, voffA);
            PG8_WAIT_L(8); PG8_BAR; PG8_WAIT_L(0); PG8_MMA(0, 0, At, B0); PG8_BAR; PG8_SCHED;
            PG8_LDB(B1, 0, 1); PG8_STAGE(PG8_SB(0, 0), b2, voffB);
            PG8_BAR; PG8_WAIT_L(0); PG8_MMA(0, 1, At, B1); PG8_BAR;
            PG8_LDA(At, 0, 1); PG8_STAGE(PG8_SA(0, 0), a2, voffA);
            PG8_BAR; PG8_WAIT_L(0); PG8_MMA(1, 0, At, B0); PG8_BAR; PG8_SCHED;
            PG8_STAGE(PG8_SB(0, 1), b2 + hstep, voffB);
            PG8_WAIT_V(6); PG8_BAR; PG8_MMA(1, 1, At, B1); PG8_BAR;
            PG8_LDB(B0, 1, 0); PG8_SCHED; PG8_LDA(At, 1, 0); PG8_STAGE(PG8_SA(0, 1), a2 + hstep, voffA);
            PG8_WAIT_L(8); PG8_BAR; PG8_WAIT_L(0); PG8_MMA(0, 0, At, B0); PG8_BAR; PG8_SCHED;
            PG8_LDB(B1, 1, 1); PG8_STAGE(PG8_SB(1, 0), b3, voffB);
            PG8_BAR; PG8_WAIT_L(0); PG8_MMA(0, 1, At, B1); PG8_BAR;
            PG8_LDA(At, 1, 1); PG8_STAGE(PG8_SA(1, 0), a3, voffA);
            PG8_BAR; PG8_WAIT_L(0); PG8_MMA(1, 0, At, B0); PG8_BAR; PG8_SCHED;
            PG8_STAGE(PG8_SB(1, 1), b3 + hstep, voffB);
            PG8_WAIT_V(6); PG8_BAR; PG8_MMA(1, 1, At, B1); PG8_BAR;
            }
        }
        if constexpr (ALIGN_EPI) { if (wr == 0) PG8_BAR; }
        if constexpr (!Epi::AFTER_DRAIN) { E(acc, cur, wr, wc, fr, fq); S.done(cur); }
        if (!has_next) break;
#pragma unroll
        for (int a = 0; a < 2; ++a)
#pragma unroll
            for (int b = 0; b < 2; ++b)
#pragma unroll
                for (int m = 0; m < 4; ++m)
#pragma unroll
                    for (int n = 0; n < 2; ++n) acc[a][b][m][n] = (f32x4){0.f, 0.f, 0.f, 0.f};
        cur = nxt; cA = nA; cB = nB; ++ui;
        if constexpr (ALIGN_EPI) { if (wr == 1) PG8_BAR; }
    }
    PG8_WAIT_V(0);
    if constexpr (!ALIGN_EPI) { if (wr == 0) PG8_BAR; }
    PG8_BAR;
    if constexpr (Epi::AFTER_DRAIN) { E.fused(acc, cur, wr, wc, fr, fq, lds, wid, lane); S.done(cur); }
#undef PG8_SA
#undef PG8_SB
#undef PG8_STAGE
#undef PG8_LDA
#undef PG8_LDB
#undef PG8_MMA
#undef PG8_WAIT_V
#undef PG8_WAIT_L
#undef PG8_BAR
#undef PG8_SCHED
}
}

constexpr int BATCH = 8, SEQ = 4096, DM = 1024, DEPTH = 4, DFF = 4096;
constexpr int M_TOK = BATCH * SEQ;
constexpr int EVEN_IN = 3072, ODD_IN = 1536;
constexpr int NWAVES = 8, NTHREADS = 512;
constexpr int LDS_BYTES = 147456;
constexpr int N_PHASES = 1 + 5 * DEPTH;

constexpr size_t MiB = 1u << 20;
constexpr size_t WS_ROWSQ = 420 * MiB;
constexpr size_t WS_BAR = 1 * MiB;
constexpr size_t WS_WMLP_IN = 2 * MiB;
constexpr size_t WS_WMLP_OUT = 34 * MiB;
constexpr size_t WS_WIN_EVEN = 66 * MiB;
constexpr size_t WS_WOUT_EVEN = 78 * MiB;
constexpr size_t WS_WIN_ODD = 82 * MiB;
constexpr size_t WS_WOUT_ODD = 88 * MiB;
constexpr size_t WS_COS = 92 * MiB, WS_SIN = 96 * MiB;
constexpr size_t WS_XB = 100 * MiB;
constexpr size_t WS_Z = 164 * MiB;
constexpr size_t WS_Y = 356 * MiB;
constexpr size_t WS_HID = 164 * MiB;
constexpr size_t WS_END = 436 * MiB;

typedef unsigned short bf16_t;
typedef short bf16x8 __attribute__((ext_vector_type(8)));
typedef float f32x4 __attribute__((ext_vector_type(4)));
typedef unsigned u32x4 __attribute__((ext_vector_type(4)));
typedef unsigned u32x2 __attribute__((ext_vector_type(2)));
#define LAS __attribute__((address_space(3)))
#define MFMA16(a, b, c) __builtin_amdgcn_mfma_f32_16x16x32_bf16((a), (b), (c), 0, 0, 0)

__device__ __forceinline__ float bf2f(unsigned u) { return __uint_as_float(u << 16); }
__device__ __forceinline__ float bflo(unsigned u) { return __uint_as_float(u << 16); }
__device__ __forceinline__ float bfhi(unsigned u) { return __uint_as_float(u & 0xffff0000u); }
__device__ __forceinline__ unsigned f2bf(float f) { unsigned u = __float_as_uint(f); return (u + 0x7fffu + ((u >> 16) & 1u)) >> 16; }
__device__ __forceinline__ unsigned pk2(float lo, float hi) { return f2bf(lo) | (f2bf(hi) << 16); }
__device__ __forceinline__ float wave_sum(float v) {
#pragma unroll
    for (int o = 1; o < 64; o <<= 1) v += __shfl_xor(v, o);
    return v;
}
__device__ __forceinline__ float red16_sum(float v) { v += __shfl_xor(v, 1); v += __shfl_xor(v, 2); v += __shfl_xor(v, 4); v += __shfl_xor(v, 8); return v; }
__device__ __forceinline__ float red16_max(float v) { v = fmaxf(v, __shfl_xor(v, 1)); v = fmaxf(v, __shfl_xor(v, 2)); v = fmaxf(v, __shfl_xor(v, 4)); v = fmaxf(v, __shfl_xor(v, 8)); return v; }
__device__ __forceinline__ bf16x8 ldfrag(const bf16_t* p) { return *(const bf16x8*)p; }

struct Args {
    const float* in[22]; const int* pos; float* out; unsigned char* ws; int ph_lo, ph_hi;
};

__device__ __forceinline__ void p0_transpose_item(const float* W, int K, int N, bf16_t* WT, const float* gain, float* scr, int item, int lane) {
    const int nblk = N / 32, kb = item / nblk, nb = item % nblk, k0 = 64 * kb, n0 = 32 * nb;
#pragma unroll 8
    for (int i = 0; i < 32; ++i) { const int kk = 2 * i + (lane >> 5); const float g = gain ? gain[k0 + kk] : 1.0f; scr[kk * 33 + (lane & 31)] = W[(size_t)(k0 + kk) * N + n0 + (lane & 31)] * g; }
    asm volatile("s_waitcnt lgkmcnt(0)" ::: "memory");
    const int c = lane & 7;
#pragma unroll
    for (int j = 0; j < 4; ++j) { const int n = (lane >> 3) + 8 * j; const float* s = scr + (8 * c) * 33 + n;
        u32x4 o; o.x = pk2(s[0 * 33], s[1 * 33]); o.y = pk2(s[2 * 33], s[3 * 33]); o.z = pk2(s[4 * 33], s[5 * 33]); o.w = pk2(s[6 * 33], s[7 * 33]);
        *(u32x4*)(WT + (size_t)(n0 + n) * K + k0 + 8 * c) = o; }
    asm volatile("s_waitcnt lgkmcnt(0)" ::: "memory");
}

__device__ __forceinline__ void p0_prologue(const Args& a, unsigned char* lds) {
    int tid_ = threadIdx.x; asm volatile("" : "+v"(tid_));
    const int tid = tid_, lane = tid & 63, wave = tid >> 6;
    const int G = gridDim.x, bid = blockIdx.x;
    const int gw = bid * NWAVES + wave, NGW = G * NWAVES;
    const int gt = bid * NTHREADS + tid, NGT = G * NTHREADS;
    unsigned char* ws = a.ws;
    float* scr = (float*)(lds + wave * 16384);
    const float* norm_mix = a.in[2]; const float* norm_mlp = a.in[3];
    constexpr int NITEMS = 4 * 4096 + 2 * 2048 + 2 * 1280;
    for (int it0 = gw; it0 < NITEMS; it0 += NGW) {
        int it = it0;
        if (it < 16384) { const int l = it >> 12, r = it & 4095;
            if (r < 2048) p0_transpose_item(a.in[4] + (size_t)l * DM * DFF, DM, DFF, (bf16_t*)(ws + WS_WMLP_IN) + (size_t)l * DM * DFF, norm_mlp + l * DM, scr, r, lane);
            else p0_transpose_item(a.in[5] + (size_t)l * DM * DFF, DFF, DM, (bf16_t*)(ws + WS_WMLP_OUT) + (size_t)l * DM * DFF, nullptr, scr, r - 2048, lane);
            continue; }
        it -= 16384;
        if (it < 4096) { const int e = it >> 11, r = it & 2047;
            if (r < 1536) p0_transpose_item(a.in[6] + (size_t)e * DM * EVEN_IN, DM, EVEN_IN, (bf16_t*)(ws + WS_WIN_EVEN) + (size_t)e * DM * EVEN_IN, norm_mix + (2 * e) * DM, scr, r, lane);
            else p0_transpose_item(a.in[7] + (size_t)e * DM * DM, DM, DM, (bf16_t*)(ws + WS_WOUT_EVEN) + (size_t)e * DM * DM, nullptr, scr, r - 1536, lane);
            continue; }
        it -= 4096;
        { const int o = it / 1280, r = it % 1280;
            if (r < 768) p0_transpose_item(a.in[17] + (size_t)o * DM * ODD_IN, DM, ODD_IN, (bf16_t*)(ws + WS_WIN_ODD) + (size_t)o * DM * ODD_IN, norm_mix + (2 * o + 1) * DM, scr, r, lane);
            else p0_transpose_item(a.in[18] + (size_t)o * DM * DM, DM, DM, (bf16_t*)(ws + WS_WOUT_ODD) + (size_t)o * DM * DM, nullptr, scr, r - 768, lane); }
    }
    { const float* x = a.in[0]; bf16_t* xb = (bf16_t*)(ws + WS_XB); float* rq0 = (float*)(ws + WS_ROWSQ);
      for (int m = gw; m < M_TOK; m += NGW) {
          const f32x4* xr = (const f32x4*)(x + (size_t)m * DM) + lane; u32x2* o8 = (u32x2*)(xb + (size_t)m * DM) + lane; float s = 0.f;
#pragma unroll
          for (int j = 0; j < 4; ++j) { const f32x4 v = xr[64 * j]; s += (v[0] * v[0] + v[1] * v[1]) + (v[2] * v[2] + v[3] * v[3]); u32x2 w; w.x = pk2(v[0], v[1]); w.y = pk2(v[2], v[3]); o8[64 * j] = w; }
          s = wave_sum(s); if (lane < 16) rq0[(size_t)m * 16 + lane] = (lane == 0) ? s : 0.f; } }
    { float* cs = (float*)(ws + WS_COS); float* sn = (float*)(ws + WS_SIN);
      for (int i = gt; i < M_TOK * 32; i += NGT) { const int tok = i >> 5, j = i & 31;
          const float invf = exp2f(-(float)j * (13.287712379549449f / 32.0f));
          const float ang = (float)a.pos[tok] * invf;
          double rev = (double)ang * 0.15915494309189535; rev -= rint(rev);
          const float fr = (float)rev;
          sn[i] = __builtin_amdgcn_sinf(fr); cs[i] = __builtin_amdgcn_cosf(fr); } }
}

__device__ __forceinline__ void hgrn_item(unsigned char* lds, int b, int h, const bf16_t* z, bf16_t* y, const float* lb_logits, int e_layer, const float* gn) {
    int tid_ = threadIdx.x; asm volatile("" : "+v"(tid_));
    const int tid = tid_, lane = tid & 63, w = tid >> 6, l15 = lane & 15, lg = lane >> 4;
    bf16_t* Qm = (bf16_t*)(lds + 0);
    bf16_t* Km = (bf16_t*)(lds + 17408);
    bf16_t* Qt = (bf16_t*)(lds + 34816);
    bf16_t* KdT = (bf16_t*)(lds + 52224);
    bf16_t* vT = (bf16_t*)(lds + 70656);
    bf16_t* ST = (bf16_t*)(lds + 89088);
    bf16_t* P = (bf16_t*)(lds + 123904);
    float* segtot = (float*)(lds + 133120);
    float* dlast = (float*)(lds + 137216);
    float* rowss = (float*)(lds + 137728);
    const int c0 = h * 128 + 2 * lane;
    float lb0 = 0.f, lb1 = 0.f;
    if (e_layer == 1) { lb0 = 1.0f / (1.0f + __expf(lb_logits[c0] - lb_logits[512 + c0])); lb1 = 1.0f / (1.0f + __expf(lb_logits[c0 + 1] - lb_logits[512 + c0 + 1])); }
    const float om0 = 1.0f - lb0, om1 = 1.0f - lb1;
    const int tt = w >> 1, eh = w & 1;
    float gnv[4];
#pragma unroll
    for (int j = 0; j < 4; ++j) gnv[j] = gn[h * 128 + 16 * (4 * eh + j) + l15];
    f32x4 S[8];
#pragma unroll
    for (int j = 0; j < 8; ++j) S[j] = (f32x4){0.f, 0.f, 0.f, 0.f};
    u32x4 rq[2], rf[2], rv[2];
    const size_t rowb = (size_t)b * SEQ;
#pragma unroll
    for (int i = 0; i < 2; ++i) { const int idx = tid + 512 * i, r = idx >> 4, ch = idx & 15; const bf16_t* p = z + (rowb + r) * EVEN_IN + h * 128 + ch * 8;
        rq[i] = *(const u32x4*)p; rf[i] = *(const u32x4*)(p + 512); rv[i] = *(const u32x4*)(p + 1024); }
    for (int c = 0; c < 64; ++c) {
        const size_t row0 = rowb + 64 * c;
#pragma unroll
        for (int i = 0; i < 2; ++i) { const int idx = tid + 512 * i, r = idx >> 4, ch = idx & 15;
            *(u32x4*)(Qm + r * 136 + ch * 8) = rq[i]; *(u32x4*)(Km + r * 136 + ch * 8) = rf[i];
            const u32x4 v = rv[i];
            vT[(ch * 8 + 0) * 72 + r] = (bf16_t)(v.x & 0xffffu); vT[(ch * 8 + 1) * 72 + r] = (bf16_t)(v.x >> 16);
            vT[(ch * 8 + 2) * 72 + r] = (bf16_t)(v.y & 0xffffu); vT[(ch * 8 + 3) * 72 + r] = (bf16_t)(v.y >> 16);
            vT[(ch * 8 + 4) * 72 + r] = (bf16_t)(v.z & 0xffffu); vT[(ch * 8 + 5) * 72 + r] = (bf16_t)(v.z >> 16);
            vT[(ch * 8 + 6) * 72 + r] = (bf16_t)(v.w & 0xffffu); vT[(ch * 8 + 7) * 72 + r] = (bf16_t)(v.w >> 16); }
#pragma unroll
        for (int j = 0; j < 8; ++j) { u32x2 pk; pk.x = pk2(S[j][0], S[j][1]); pk.y = pk2(S[j][2], S[j][3]); *(u32x2*)(ST + (16 * j + l15) * 136 + 16 * w + 4 * lg) = pk; }
        if (c + 1 < 64) {
#pragma unroll
            for (int i = 0; i < 2; ++i) { const int idx = tid + 512 * i, r = idx >> 4, ch = idx & 15; const bf16_t* p = z + (row0 + 64 + r) * EVEN_IN + h * 128 + ch * 8;
                rq[i] = *(const u32x4*)p; rf[i] = *(const u32x4*)(p + 512); rv[i] = *(const u32x4*)(p + 1024); } }
        __syncthreads();
        float kk0[8], kk1[8], bl0[8], bl1[8]; float cum0 = 0.f, cum1 = 0.f;
#pragma unroll
        for (int i = 0; i < 8; ++i) { const int t = 8 * w + i; const unsigned fx2 = *(const unsigned*)(Km + t * 136 + 2 * lane);
            const float fx0 = bflo(fx2), fx1 = bfhi(fx2);
            const float e0 = __expf(-fx0), e1 = __expf(-fx1); const float s0 = 1.0f / (1.0f + e0), s1 = 1.0f / (1.0f + e1);
            const float f0 = lb0 + om0 * s0, f1 = lb1 + om1 * s1;
            cum0 += __logf(fmaxf(f0, 1e-30f)); cum1 += __logf(fmaxf(f1, 1e-30f));
            bl0[i] = cum0; bl1[i] = cum1; kk0[i] = om0 * e0 * s0; kk1[i] = om1 * e1 * s1; }
        segtot[w * 128 + 2 * lane] = cum0; segtot[w * 128 + 2 * lane + 1] = cum1;
        __syncthreads();
        float off0 = 0.f, off1 = 0.f, mid0 = 0.f, mid1 = 0.f, la0 = 0.f, la1 = 0.f;
#pragma unroll
        for (int s = 0; s < 8; ++s) { const float a0 = segtot[s * 128 + 2 * lane], a1 = segtot[s * 128 + 2 * lane + 1];
            if (s < w) { off0 += a0; off1 += a1; } if (s < 4) { mid0 += a0; mid1 += a1; } la0 += a0; la1 += a1; }
        unsigned kd0[4], kd1[4];
#pragma unroll
        for (int i = 0; i < 8; ++i) { const int t = 8 * w + i; const unsigned q2 = *(const unsigned*)(Qm + t * 136 + 2 * lane);
            const float q0 = bflo(q2), q1 = bfhi(q2); const float b0 = off0 + bl0[i], b1 = off1 + bl1[i];
            const float qm0 = q0 * __expf(fminf(b0 - mid0, 80.f)), qm1 = q1 * __expf(fminf(b1 - mid1, 80.f));
            const float km0 = kk0[i] * __expf(fminf(mid0 - b0, 80.f)), km1 = kk1[i] * __expf(fminf(mid1 - b1, 80.f));
            const float qt0 = q0 * __expf(b0), qt1 = q1 * __expf(b1);
            const float kdv0 = kk0[i] * __expf(la0 - b0), kdv1 = kk1[i] * __expf(la1 - b1);
            *(unsigned*)(Qm + t * 136 + 2 * lane) = pk2(qm0, qm1); *(unsigned*)(Km + t * 136 + 2 * lane) = pk2(km0, km1); *(unsigned*)(Qt + t * 136 + 2 * lane) = pk2(qt0, qt1);
            if (i & 1) { kd0[i >> 1] |= f2bf(kdv0) << 16; kd1[i >> 1] |= f2bf(kdv1) << 16; } else { kd0[i >> 1] = f2bf(kdv0); kd1[i >> 1] = f2bf(kdv1); } }
        { u32x4 t0; t0.x = kd0[0]; t0.y = kd0[1]; t0.z = kd0[2]; t0.w = kd0[3]; *(u32x4*)(KdT + (2 * lane) * 72 + 8 * w) = t0;
          u32x4 t1; t1.x = kd1[0]; t1.y = kd1[1]; t1.z = kd1[2]; t1.w = kd1[3]; *(u32x4*)(KdT + (2 * lane + 1) * 72 + 8 * w) = t1; }
        if (w == 0) { dlast[2 * lane] = __expf(la0); dlast[2 * lane + 1] = __expf(la1); }
        __syncthreads();
        unsigned gav[4][4];
#pragma unroll
        for (int reg = 0; reg < 4; ++reg)
#pragma unroll
            for (int j = 0; j < 4; ++j) gav[reg][j] = z[(row0 + 16 * tt + 4 * lg + reg) * EVEN_IN + 1536 + h * 128 + 16 * (4 * eh + j) + l15];
#pragma unroll
        for (int sti = 0; sti < 2; ++sti) { const int st = 2 * eh + sti; f32x4 acc = (f32x4){0.f, 0.f, 0.f, 0.f};
            if (st <= tt) {
#pragma unroll
                for (int ks = 0; ks < 4; ++ks) acc = MFMA16(ldfrag(Qm + (16 * tt + l15) * 136 + 32 * ks + 8 * lg), ldfrag(Km + (16 * st + l15) * 136 + 32 * ks + 8 * lg), acc); }
#pragma unroll
            for (int reg = 0; reg < 4; ++reg) { const int t = 16 * tt + 4 * lg + reg, s = 16 * st + l15; const float v = (st <= tt && s <= t) ? acc[reg] : 0.f; P[t * 72 + s] = (bf16_t)f2bf(v); } }
        { float dl[4];
#pragma unroll
          for (int reg = 0; reg < 4; ++reg) dl[reg] = dlast[16 * w + 4 * lg + reg];
          const bf16x8 a0 = ldfrag(KdT + (16 * w + l15) * 72 + 8 * lg), a1 = ldfrag(KdT + (16 * w + l15) * 72 + 32 + 8 * lg);
#pragma unroll
          for (int j = 0; j < 8; ++j) { f32x4 sv = S[j];
#pragma unroll
              for (int reg = 0; reg < 4; ++reg) sv[reg] *= dl[reg];
              sv = MFMA16(a0, ldfrag(vT + (16 * j + l15) * 72 + 8 * lg), sv); sv = MFMA16(a1, ldfrag(vT + (16 * j + l15) * 72 + 32 + 8 * lg), sv); S[j] = sv; } }
        __syncthreads();
        f32x4 o[4];
        { bf16x8 qa[4], pa[2];
#pragma unroll
          for (int ks = 0; ks < 4; ++ks) qa[ks] = ldfrag(Qt + (16 * tt + l15) * 136 + 32 * ks + 8 * lg);
#pragma unroll
          for (int ks = 0; ks < 2; ++ks) pa[ks] = ldfrag(P + (16 * tt + l15) * 72 + 32 * ks + 8 * lg);
#pragma unroll
          for (int j = 0; j < 4; ++j) { const int et = 4 * eh + j; f32x4 acc = (f32x4){0.f, 0.f, 0.f, 0.f};
#pragma unroll
              for (int ks = 0; ks < 4; ++ks) acc = MFMA16(qa[ks], ldfrag(ST + (16 * et + l15) * 136 + 32 * ks + 8 * lg), acc);
#pragma unroll
              for (int ks = 0; ks < 2; ++ks) acc = MFMA16(pa[ks], ldfrag(vT + (16 * et + l15) * 72 + 32 * ks + 8 * lg), acc);
              o[j] = acc; } }
#pragma unroll
        for (int reg = 0; reg < 4; ++reg) { float ss = 0.f;
#pragma unroll
            for (int j = 0; j < 4; ++j) ss += o[j][reg] * o[j][reg];
            ss = red16_sum(ss); if (l15 == 0) rowss[(16 * tt + 4 * lg + reg) * 2 + eh] = ss; }
        __syncthreads();
#pragma unroll
        for (int reg = 0; reg < 4; ++reg) { const int t = 16 * tt + 4 * lg + reg; const float rs = rsqrtf((rowss[t * 2] + rowss[t * 2 + 1]) * (1.0f / 128.0f) + 1e-6f);
#pragma unroll
            for (int j = 0; j < 4; ++j) { const float ga = bf2f(gav[reg][j]); const float val = o[j][reg] * rs * gnv[j] * (ga / (1.0f + __expf(-ga)));
                y[(row0 + t) * DM + h * 128 + 16 * (4 * eh + j) + l15] = (bf16_t)f2bf(val); } }
    }
    __syncthreads();
}

__device__ __forceinline__ void rglru_item(unsigned char* lds, int b, int n, int jq, const bf16_t* z, bf16_t* y, const float* conv_w, const float* conv_b,
                                           const float* wa, const float* ba, const float* wx, const float* bx, const float* lam) {
    int tid_ = threadIdx.x; asm volatile("" : "+v"(tid_));
    const int tid = tid_, lane = tid & 63, w = tid >> 6, l15 = lane & 15, lg = lane >> 4;
    bf16_t* raw = (bf16_t*)(lds);
    bf16_t* xcA = (bf16_t*)(lds + 33280);
    bf16_t* Wt = (bf16_t*)(lds + 70144);
    float* G = (float*)(lds + 74752);
    float* AH = (float*)(lds + 108544);
    for (int idx = tid; idx < 32 * 64; idx += NTHREADS) { const int jj = idx >> 6, i = idx & 63;
        const float v = (jj < 16) ? wa[((size_t)n * 64 + i) * 64 + 16 * jq + jj] : wx[((size_t)n * 64 + i) * 64 + 16 * jq + jj - 16];
        Wt[jj * 72 + i] = (bf16_t)f2bf(v); }
    const int j = tid & 15, seg = tid >> 4;
    const int cch = 64 * n + 16 * jq + j;
    const float bav = ba[cch], bxv = bx[cch];
    const float c8 = -8.0f * log1pf(expf(-lam[cch]));
    const float cw0 = conv_w[cch], cw1 = conv_w[512 + cch], cw2 = conv_w[1024 + cch], cw3 = conv_w[1536 + cch], cbv = conv_b[cch];
    const int o8 = tid & 7;
    float cwo[4][8], cbo[8];
#pragma unroll
    for (int k = 0; k < 8; ++k) { cbo[k] = conv_b[64 * n + o8 * 8 + k];
#pragma unroll
        for (int wi = 0; wi < 4; ++wi) cwo[wi][k] = conv_w[wi * 512 + 64 * n + o8 * 8 + k]; }
    float h_in = 0.f;
    const size_t rowb = (size_t)b * SEQ;
    for (int tile = 0; tile < 16; ++tile) {
        const int t0 = tile * 256;
        for (int idx = tid; idx < 259 * 8; idx += NTHREADS) { const int r = idx >> 3, oc = idx & 7; const int tok = t0 - 3 + r;
            u32x4 v = (u32x4){0u, 0u, 0u, 0u};
            if (tok >= 0) v = *(const u32x4*)(z + (rowb + tok) * EVEN_IN + 2560 + 64 * n + oc * 8);
            *(u32x4*)(raw + r * 64 + oc * 8) = v; }
        __syncthreads();
#pragma unroll
        for (int i = 0; i < 4; ++i) { const int idx = tid + 512 * i, t = idx >> 3; float acc[8];
#pragma unroll
            for (int k = 0; k < 8; ++k) acc[k] = cbo[k];
#pragma unroll
            for (int wi = 0; wi < 4; ++wi) { const u32x4 v = *(const u32x4*)(raw + (t + wi) * 64 + o8 * 8);
                acc[0] += cwo[wi][0] * bflo(v.x); acc[1] += cwo[wi][1] * bfhi(v.x); acc[2] += cwo[wi][2] * bflo(v.y); acc[3] += cwo[wi][3] * bfhi(v.y);
                acc[4] += cwo[wi][4] * bflo(v.z); acc[5] += cwo[wi][5] * bfhi(v.z); acc[6] += cwo[wi][6] * bflo(v.w); acc[7] += cwo[wi][7] * bfhi(v.w); }
            u32x4 o; o.x = pk2(acc[0], acc[1]); o.y = pk2(acc[2], acc[3]); o.z = pk2(acc[4], acc[5]); o.w = pk2(acc[6], acc[7]);
            *(u32x4*)(xcA + t * 72 + o8 * 8) = o; }
        __syncthreads();
#pragma unroll
        for (int mi = 0; mi < 2; ++mi) { const int mt = 2 * w + mi;
            const bf16x8 a0 = ldfrag(xcA + (16 * mt + l15) * 72 + 8 * lg), a1 = ldfrag(xcA + (16 * mt + l15) * 72 + 32 + 8 * lg);
#pragma unroll
            for (int nt = 0; nt < 2; ++nt) { f32x4 acc = (f32x4){0.f, 0.f, 0.f, 0.f};
                acc = MFMA16(a0, ldfrag(Wt + (16 * nt + l15) * 72 + 8 * lg), acc); acc = MFMA16(a1, ldfrag(Wt + (16 * nt + l15) * 72 + 32 + 8 * lg), acc);
#pragma unroll
                for (int reg = 0; reg < 4; ++reg) G[(16 * mt + 4 * lg + reg) * 33 + 16 * nt + l15] = acc[reg]; } }
        __syncthreads();
        float av[8], uv[8]; unsigned gb[8]; float Ac = 1.f, Hc = 0.f;
#pragma unroll
        for (int i = 0; i < 8; ++i) gb[i] = z[(rowb + t0 + 8 * seg + i) * EVEN_IN + 2048 + cch];
#pragma unroll
        for (int i = 0; i < 8; ++i) { const int t = 8 * seg + i;
            const float gr = G[t * 33 + j] + bav, gi = G[t * 33 + 16 + j] + bxv;
            const float r = 1.0f / (1.0f + __expf(-gr)), ig = 1.0f / (1.0f + __expf(-gi));
            const float la = c8 * r; const float aa = __expf(la); const float m2 = sqrtf(fmaxf(-expm1f(2.0f * la), 0.f));
            const int cl = 16 * jq + j;
            const float xf = cbv + cw0 * bf2f(raw[(t + 0) * 64 + cl]) + cw1 * bf2f(raw[(t + 1) * 64 + cl]) + cw2 * bf2f(raw[(t + 2) * 64 + cl]) + cw3 * bf2f(raw[(t + 3) * 64 + cl]);
            const float u = m2 * (ig * xf);
            av[i] = aa; uv[i] = u; Ac *= aa; Hc = aa * Hc + u; }
        AH[(seg * 16 + j) * 2] = Ac; AH[(seg * 16 + j) * 2 + 1] = Hc;
        __syncthreads();
        float cur = h_in, hs = 0.f;
        for (int s = 0; s < 32; ++s) { const float As = AH[(s * 16 + j) * 2], Hs = AH[(s * 16 + j) * 2 + 1]; if (s == seg) hs = cur; cur = As * cur + Hs; }
        float hh = hs;
#pragma unroll
        for (int i = 0; i < 8; ++i) { hh = av[i] * hh + uv[i]; const float g = bf2f(gb[i]);
            const float u = 0.7978845608028654f * (g + 0.044715f * g * g * g); const float th = 1.0f - 2.0f / (1.0f + __expf(2.0f * u));
            const float ge = 0.5f * g * (1.0f + th);
            y[(rowb + t0 + 8 * seg + i) * DM + 512 + cch] = (bf16_t)f2bf(hh * ge); }
        h_in = cur;
    }
    __syncthreads();
}

__device__ __forceinline__ void qk_prep(const bf16_t* src, const float* gain, const float* cs, const float* sn, int p, float scale, bf16_t* dst) {
    const u32x4 r1 = *(const u32x4*)(src + 8 * p), r2 = *(const u32x4*)(src + 32 + 8 * p);
    float x1[8], x2[8];
    x1[0] = bflo(r1.x); x1[1] = bfhi(r1.x); x1[2] = bflo(r1.y); x1[3] = bfhi(r1.y); x1[4] = bflo(r1.z); x1[5] = bfhi(r1.z); x1[6] = bflo(r1.w); x1[7] = bfhi(r1.w);
    x2[0] = bflo(r2.x); x2[1] = bfhi(r2.x); x2[2] = bflo(r2.y); x2[3] = bfhi(r2.y); x2[4] = bflo(r2.z); x2[5] = bfhi(r2.z); x2[6] = bflo(r2.w); x2[7] = bfhi(r2.w);
    float ss = 0.f;
#pragma unroll
    for (int i = 0; i < 8; ++i) ss += x1[i] * x1[i] + x2[i] * x2[i];
    ss += __shfl_xor(ss, 1); ss += __shfl_xor(ss, 2);
    const float rs = rsqrtf(ss * (1.0f / 64.0f) + 1e-6f);
    const f32x4 ca = *(const f32x4*)(cs + 8 * p), cb = *(const f32x4*)(cs + 8 * p + 4), sa = *(const f32x4*)(sn + 8 * p), sb = *(const f32x4*)(sn + 8 * p + 4);
    const f32x4 g1a = *(const f32x4*)(gain + 8 * p), g1b = *(const f32x4*)(gain + 8 * p + 4), g2a = *(const f32x4*)(gain + 32 + 8 * p), g2b = *(const f32x4*)(gain + 32 + 8 * p + 4);
    float o1[8], o2[8];
#pragma unroll
    for (int i = 0; i < 8; ++i) { const float c = (i < 4) ? ca[i & 3] : cb[i & 3], s = (i < 4) ? sa[i & 3] : sb[i & 3];
        const float g1 = (i < 4) ? g1a[i & 3] : g1b[i & 3], g2 = (i < 4) ? g2a[i & 3] : g2b[i & 3];
        const float y1 = x1[i] * rs * g1, y2 = x2[i] * rs * g2;
        o1[i] = (y1 * c - y2 * s) * scale; o2[i] = (y2 * c + y1 * s) * scale; }
    u32x4 w1, w2; w1.x = pk2(o1[0], o1[1]); w1.y = pk2(o1[2], o1[3]); w1.z = pk2(o1[4], o1[5]); w1.w = pk2(o1[6], o1[7]);
    w2.x = pk2(o2[0], o2[1]); w2.y = pk2(o2[2], o2[3]); w2.z = pk2(o2[4], o2[5]); w2.w = pk2(o2[6], o2[7]);
    *(u32x4*)(dst + 8 * p) = w1; *(u32x4*)(dst + 32 + 8 * p) = w2;
}

__device__ __forceinline__ void swa_item(unsigned char* lds, int b, int n, int kvh, const bf16_t* z, bf16_t* y, const float* cosT, const float* sinT,
                                         const float* qn, const float* kn, const float* sinks) {
    int tid_ = threadIdx.x; asm volatile("" : "+v"(tid_));
    const int tid = tid_, lane = tid & 63, w = tid >> 6, l15 = lane & 15, lg = lane >> 4;
    bf16_t* Ks = (bf16_t*)lds;
    bf16_t* VT = (bf16_t*)(lds + 36864);
    bf16_t* Qs = (bf16_t*)(lds + 72704);
    bf16_t* Pw = (bf16_t*)(lds + 91136) + w * (16 * 168);
    const size_t tok0 = (size_t)b * SEQ + 128 * n;
    const int prow = tid >> 2, pp = tid & 3;
#pragma unroll
    for (int pass = 0; pass < 2; ++pass) { const int lrow = pass * 128 + prow;
        if (pass == 0 && n == 0) { const u32x4 zz = (u32x4){0u, 0u, 0u, 0u}; *(u32x4*)(Ks + lrow * 72 + 8 * pp) = zz; *(u32x4*)(Ks + lrow * 72 + 32 + 8 * pp) = zz; }
        else { const size_t tok = tok0 - 128 + lrow; qk_prep(z + tok * ODD_IN + 1024 + kvh * 64, kn, cosT + tok * 32, sinT + tok * 32, pp, 1.0f, Ks + lrow * 72); } }
#pragma unroll
    for (int i = 0; i < 4; ++i) { const int idx = tid + 512 * i, r = idx >> 3, c8 = idx & 7; u32x4 v = (u32x4){0u, 0u, 0u, 0u};
        if (!(n == 0 && r < 128)) v = *(const u32x4*)(z + (tok0 - 128 + r) * ODD_IN + 1280 + kvh * 64 + c8 * 8);
        VT[(c8 * 8 + 0) * 280 + r] = (bf16_t)(v.x & 0xffffu); VT[(c8 * 8 + 1) * 280 + r] = (bf16_t)(v.x >> 16);
        VT[(c8 * 8 + 2) * 280 + r] = (bf16_t)(v.y & 0xffffu); VT[(c8 * 8 + 3) * 280 + r] = (bf16_t)(v.y >> 16);
        VT[(c8 * 8 + 4) * 280 + r] = (bf16_t)(v.z & 0xffffu); VT[(c8 * 8 + 5) * 280 + r] = (bf16_t)(v.z >> 16);
        VT[(c8 * 8 + 6) * 280 + r] = (bf16_t)(v.w & 0xffffu); VT[(c8 * 8 + 7) * 280 + r] = (bf16_t)(v.w >> 16); }
    for (int idx = tid; idx < 64 * 24; idx += NTHREADS) VT[(idx / 24) * 280 + 256 + (idx % 24)] = 0;
    for (int g = 0; g < 4; ++g) {
        const int hq = kvh * 4 + g;
        __syncthreads();
        qk_prep(z + (tok0 + prow) * ODD_IN + hq * 64, qn, cosT + (tok0 + prow) * 32, sinT + (tok0 + prow) * 32, pp, 0.125f, Qs + prow * 72);
        __syncthreads();
        const float sink = sinks[hq];
        const bf16x8 qa0 = ldfrag(Qs + (16 * w + l15) * 72 + 8 * lg), qa1 = ldfrag(Qs + (16 * w + l15) * 72 + 32 + 8 * lg);
        f32x4 sc[9];
#pragma unroll
        for (int kt = 0; kt < 9; ++kt) { const int kr = 16 * (w + kt) + l15; f32x4 acc = (f32x4){0.f, 0.f, 0.f, 0.f};
            acc = MFMA16(qa0, ldfrag(Ks + kr * 72 + 8 * lg), acc); acc = MFMA16(qa1, ldfrag(Ks + kr * 72 + 32 + 8 * lg), acc); sc[kt] = acc; }
        float mx[4], sm[4], inv[4];
#pragma unroll
        for (int reg = 0; reg < 4; ++reg) { const int qi = 16 * w + 4 * lg + reg; float m = -1e30f;
#pragma unroll
            for (int kt = 0; kt < 9; ++kt) { const int ki = 16 * (w + kt) + l15; const int rel = qi + 128 - ki;
                const bool valid = (rel >= 0) && (rel < 128) && (n > 0 || ki >= 128);
                const float v = valid ? sc[kt][reg] : -1e30f; sc[kt][reg] = v; m = fmaxf(m, v); }
            m = red16_max(m); mx[reg] = fmaxf(m, sink); }
#pragma unroll
        for (int reg = 0; reg < 4; ++reg) { float s = 0.f;
#pragma unroll
            for (int kt = 0; kt < 9; ++kt) { const float p = __expf(sc[kt][reg] - mx[reg]); s += p; Pw[(4 * lg + reg) * 168 + 16 * kt + l15] = (bf16_t)f2bf(p); }
            Pw[(4 * lg + reg) * 168 + 144 + l15] = 0;
            s = red16_sum(s); sm[reg] = s; inv[reg] = 1.0f / (s + __expf(sink - mx[reg])); }
        asm volatile("s_waitcnt lgkmcnt(0)" ::: "memory");
        bf16x8 pa[5];
#pragma unroll
        for (int ks = 0; ks < 5; ++ks) pa[ks] = ldfrag(Pw + l15 * 168 + 32 * ks + 8 * lg);
#pragma unroll
        for (int dt = 0; dt < 4; ++dt) { f32x4 acc = (f32x4){0.f, 0.f, 0.f, 0.f};
#pragma unroll
            for (int ks = 0; ks < 5; ++ks) acc = MFMA16(pa[ks], ldfrag(VT + (16 * dt + l15) * 280 + 16 * w + 32 * ks + 8 * lg), acc);
#pragma unroll
            for (int reg = 0; reg < 4; ++reg) y[(tok0 + 16 * w + 4 * lg + reg) * DM + hq * 64 + 16 * dt + l15] = (bf16_t)f2bf(acc[reg] * inv[reg]); }
    }
    __syncthreads();
}

#ifndef MK_MULTI
#define MK_MULTI 1
#endif
__global__ void __launch_bounds__(NTHREADS, 2) trunk_fwd(Args a) {
    extern __shared__ __attribute__((aligned(16))) unsigned char lds[];
    cg::grid_group grid = cg::this_grid();
    const int G = gridDim.x, bid = blockIdx.x;
    unsigned char* ws = a.ws;
    float* rowsq = (float*)(ws + WS_ROWSQ);
    bf16_t* XB = (bf16_t*)(ws + WS_XB); bf16_t* Z = (bf16_t*)(ws + WS_Z); bf16_t* Y = (bf16_t*)(ws + WS_Y); bf16_t* HID = (bf16_t*)(ws + WS_HID);
    const float* cosT = (const float*)(ws + WS_COS); const float* sinT = (const float*)(ws + WS_SIN);
    const int lo = a.ph_lo, hi = a.ph_hi;
#define IN(k) (lo <= (k) && (k) < hi)
#define SEAM(k) do { if (IN(k) && IN((k) + 1)) grid.sync(); } while (0)
#ifndef NO_P0
    if (IN(0)) { p0_prologue(a, lds); __syncthreads(); }
#endif
    SEAM(0);
    for (int l = 0; l < DEPTH; ++l) {
        const int pb = 1 + 5 * l; const bool even = (l & 1) == 0; const int li = l >> 1;
        if (IN(pb)) {
            const int N = even ? EVEN_IN : ODD_IN;
            const bf16_t* Wt = even ? (const bf16_t*)(ws + WS_WIN_EVEN) + (size_t)li * DM * EVEN_IN : (const bf16_t*)(ws + WS_WIN_ODD) + (size_t)li * DM * ODD_IN;
            pg8::Gemm g{XB, Wt, M_TOK, N, DM}; pg8::StaticOrder S; S.init(M_TOK, N, G, bid);
            pg8::EpiScaleBf16<0> E{Z, N, rowsq + (size_t)(2 * l) * M_TOK * 16};
#if !defined(NO_GEMM) && !defined(NO_G1)
            pg8::gemm_phase<pg8::EpiScaleBf16<0>, pg8::StaticOrder, true, true>((LAS unsigned char*)lds, g, S, E);
#endif
        }
        SEAM(pb);
        if (IN(pb + 1)) {
            if (even) {
#ifndef NO_HGRN
                if (bid < 32) hgrn_item(lds, bid >> 2, bid & 3, Z, Y, a.in[8], li, a.in[9] + li * 512);
#endif
#ifndef NO_RG
                if (bid >= 32) for (int it = bid - 32; it < 256; it += G - 32)
                    rglru_item(lds, it >> 5, (it >> 2) & 7, it & 3, Z, Y, a.in[10] + li * 2048, a.in[11] + li * 512, a.in[12] + (size_t)li * 32768, a.in[13] + li * 512,
                               a.in[14] + (size_t)li * 32768, a.in[15] + li * 512, a.in[16] + li * 512);
#endif
            } else {
#ifndef NO_SWA
                for (int it = bid; it < 1024; it += G)
                    swa_item(lds, it >> 7, (it >> 2) & 31, it & 3, Z, Y, cosT, sinT, a.in[19] + li * 64, a.in[20] + li * 64, a.in[21] + li * 16);
#endif
            }
        }
        SEAM(pb + 1);
        if (IN(pb + 2)) {
            const bf16_t* Wt = even ? (const bf16_t*)(ws + WS_WOUT_EVEN) + (size_t)li * DM * DM : (const bf16_t*)(ws + WS_WOUT_ODD) + (size_t)li * DM * DM;
            pg8::Gemm g{Y, Wt, M_TOK, DM, DM}; pg8::StaticOrder S; S.init(M_TOK, DM, G, bid);
            pg8::EpiResid E{l == 0 ? a.in[0] : a.out, a.out, XB, rowsq + (size_t)(2 * l + 1) * M_TOK * 16, DM};
#if !defined(NO_GEMM) && !defined(NO_G2)
            pg8::gemm_phase<pg8::EpiResid, pg8::StaticOrder, true, true>((LAS unsigned char*)lds, g, S, E);
#endif
        }
        SEAM(pb + 2);
        if (IN(pb + 3)) {
            pg8::Gemm g{XB, (const bf16_t*)(ws + WS_WMLP_IN) + (size_t)l * DM * DFF, M_TOK, DFF, DM}; pg8::StaticOrder S; S.init(M_TOK, DFF, G, bid);
            pg8::EpiScaleBf16<1> E{HID, DFF, rowsq + (size_t)(2 * l + 1) * M_TOK * 16};
#if !defined(NO_GEMM) && !defined(NO_G3)
            pg8::gemm_phase<pg8::EpiScaleBf16<1>, pg8::StaticOrder, true, true>((LAS unsigned char*)lds, g, S, E);
#endif
        }
        SEAM(pb + 3);
        if (IN(pb + 4)) {
            pg8::Gemm g{HID, (const bf16_t*)(ws + WS_WMLP_OUT) + (size_t)l * DM * DFF, M_TOK, DM, DFF}; pg8::StaticOrder S; S.init(M_TOK, DM, G, bid);
            pg8::EpiResid E{a.out, a.out, XB, (l + 1 < DEPTH) ? rowsq + (size_t)(2 * l + 2) * M_TOK * 16 : nullptr, DM};
#if !defined(NO_GEMM) && !defined(NO_G4)
            pg8::gemm_phase<pg8::EpiResid, pg8::StaticOrder, true, true>((LAS unsigned char*)lds, g, S, E);
#endif
        }
        SEAM(pb + 4);
    }
#undef IN
#undef SEAM
}

extern "C" void kernel_launch(void* const* d_in, const int* in_sizes, int n_in, void* d_out, int out_size, void* d_ws, size_t ws_size, hipStream_t stream) {
    static int grid = 0;
    if (grid == 0) {
        if (n_in != 22 || out_size != M_TOK * DM || ws_size < WS_END) { fprintf(stderr, "kernel_launch: unexpected shapes (n_in %d out %d ws %zu)\n", n_in, out_size, ws_size); grid = -1; return; }
        int dev = 0, cus = 0, per_cu = 0;
        (void)hipGetDevice(&dev); (void)hipDeviceGetAttribute(&cus, hipDeviceAttributeMultiprocessorCount, dev);
        if (hipFuncSetAttribute((const void*)trunk_fwd, hipFuncAttributeMaxDynamicSharedMemorySize, LDS_BYTES) != hipSuccess) { fprintf(stderr, "kernel_launch: hipFuncSetAttribute failed\n"); grid = -1; return; }
        if (hipOccupancyMaxActiveBlocksPerMultiprocessor(&per_cu, (const void*)trunk_fwd, NTHREADS, LDS_BYTES) != hipSuccess || per_cu < 1) { fprintf(stderr, "kernel_launch: occupancy query says %d\n", per_cu); per_cu = 1; }
        (void)hipGetLastError();
        grid = cus;
    }
    if (grid < 0) return;
    Args a{};
    for (int i = 0; i < 22; ++i) a.in[i] = (const float*)d_in[i];
    a.pos = (const int*)d_in[1]; a.out = (float*)d_out; a.ws = (unsigned char*)d_ws;
#if MK_MULTI
    for (int ph = 0; ph < N_PHASES; ++ph) { a.ph_lo = ph; a.ph_hi = ph + 1; hipLaunchKernelGGL(trunk_fwd, dim3(grid), dim3(NTHREADS), LDS_BYTES, stream, a); }
#else
    a.ph_lo = 0; a.ph_hi = N_PHASES;
    void* args[] = {&a};
    hipError_t e = hipLaunchCooperativeKernel((const void*)trunk_fwd, dim3(grid), dim3(NTHREADS), args, LDS_BYTES, stream);
    if (e != hipSuccess) fprintf(stderr, "cooperative launch failed: %s (grid %d)\n", hipGetErrorString(e), grid);
#endif
}
```

```cpp
#include <hip/hip_runtime.h>
#include <hip/hip_cooperative_groups.h>
#include <cstdio>
#include <cstdint>
namespace cg = cooperative_groups;
namespace pg8 {
#define PG8_LAS __attribute__((address_space(3)))
typedef unsigned short bf16_t;
typedef short bf16x8 __attribute__((ext_vector_type(8)));
typedef float f32x4 __attribute__((ext_vector_type(4)));
typedef unsigned u32x4 __attribute__((ext_vector_type(4)));
constexpr int BM = 256, BK = 64, HALF = 128, HTB = HALF * BK * 2  , STAGE_BYTES = 8 * HTB, NXCD = 8, WGM = 8;

__host__ __device__ __forceinline__ int lds_byte(int r, int c) { const int st = (r >> 4) * 2 + (c >> 5), rr = r & 15, cc = c & 31, ob = rr * 64 + cc * 2; return st * 1024 + (ob ^ (((ob >> 9) & 1) << 5)); }
__host__ __device__ __forceinline__ void stage_rc(int b, int& R, int& C) { const int st = b / 1024, sb = b % 1024, swz = sb ^ (((sb >> 9) & 1) << 5); R = (st >> 1) * 16 + swz / 64; C = (st & 1) * 32 + (swz % 64) / 2; }
__host__ __device__ __forceinline__ int perm32(int rho) { const int n = rho >> 4, i = rho & 15; return 8 * (i >> 2) + 4 * n + (i & 3); }

struct Unit { int pm, pn; };
struct Gemm { const bf16_t* A; const bf16_t* Bt; int M, N, K; };

struct StaticOrder {
    int nM, nN, nwg, G, c;
    __host__ __device__ void init(int M, int N, int G_, int c_) { nM = M / BM; nN = N / BM; nwg = nM * nN; G = G_; c = c_; }
    __host__ __device__ bool next(int i, Unit& u) const {
        const long L = (long)i * G + c; if (L >= nwg) return false;
        int wgid = (int)L; { const int q = nwg / NXCD, r = nwg % NXCD, xcd = wgid % NXCD, off = wgid / NXCD; wgid = (xcd < r ? xcd * (q + 1) : r * (q + 1) + (xcd - r) * q) + off; }
        const int nig = WGM * nN, gid = wgid / nig, fm = gid * WGM, gsz = (nM - fm) < WGM ? (nM - fm) : WGM;
        u.pm = fm + ((wgid % nig) % gsz); u.pn = (wgid % nig) / gsz; return true;
    }
    __device__ __forceinline__ void a_ready(const Unit&) const {}
    __device__ __forceinline__ void done(const Unit&) const {}
};
__device__ __forceinline__ unsigned cvt_pk_bf16(float lo, float hi) { unsigned r; asm volatile("v_cvt_pk_bf16_f32 %0, %1, %2" : "=v"(r) : "v"(lo), "v"(hi)); return r; }
template <int ACT> struct EpiScaleBf16 {
    static constexpr bool PERM = true, AFTER_DRAIN = false;
    bf16_t* O; int ldc; const float* rowsq;
    __device__ __forceinline__ void operator()(const f32x4 (&acc)[2][2][4][2], const Unit& u, int wr, int wc, int fr, int fq) const {
        const int row0 = u.pm * BM + wr * 64 + fr; const int col0 = u.pn * BM + wc * 32 + 8 * fq;
        f32x4 pr[2][4];
#pragma unroll
        for (int ai = 0; ai < 2; ++ai)
#pragma unroll
            for (int m = 0; m < 4; ++m) pr[ai][m] = *(const f32x4*)(rowsq + (size_t)(row0 + ai * HALF + m * 16) * 16 + 4 * fq);
        float rsv[2][4];
#pragma unroll
        for (int ai = 0; ai < 2; ++ai)
#pragma unroll
            for (int m = 0; m < 4; ++m) { float t = (pr[ai][m][0] + pr[ai][m][1]) + (pr[ai][m][2] + pr[ai][m][3]); t += __shfl_xor(t, 16); t += __shfl_xor(t, 32); rsv[ai][m] = rsqrtf(t * (1.0f / 1024.0f) + 1e-6f); }
#pragma unroll
        for (int ai = 0; ai < 2; ++ai)
#pragma unroll
            for (int m = 0; m < 4; ++m) { const int row = row0 + ai * HALF + m * 16; const float s = rsv[ai][m];
                bf16_t* rowp = O + (size_t)row * ldc + col0;
#pragma unroll
                for (int bj = 0; bj < 2; ++bj) { f32x4 v0 = acc[ai][bj][m][0] * s, v1 = acc[ai][bj][m][1] * s;
                    if (ACT == 1) {
#pragma unroll
                        for (int q = 0; q < 4; ++q) { const float a = fmaxf(v0[q], 0.f), b = fmaxf(v1[q], 0.f); v0[q] = a * a; v1[q] = b * b; } }
                    u32x4 w; w.x = cvt_pk_bf16(v0[0], v0[1]); w.y = cvt_pk_bf16(v0[2], v0[3]); w.z = cvt_pk_bf16(v1[0], v1[1]); w.w = cvt_pk_bf16(v1[2], v1[3]);
                    if (ACT == 1) __builtin_nontemporal_store(w, (u32x4*)(rowp + bj * HALF)); else *(u32x4*)(rowp + bj * HALF) = w; } }
    }
};
struct EpiResid {
    static constexpr bool PERM = true, AFTER_DRAIN = false;
    bf16_t* hi; bf16_t* lo; float* fin; float* rowsq_next; int ldc;
    __device__ __forceinline__ void operator()(const f32x4 (&acc)[2][2][4][2], const Unit& u, int wr, int wc, int fr, int fq) const {
        const int row0 = u.pm * BM + wr * 64 + fr; const int col0 = u.pn * BM + wc * 32 + 8 * fq;
        u32x4 ph[8][2], pl[8][2];
#define ER_GLD(dst, p, OFF) asm volatile("global_load_dwordx4 %0, %1, off offset:" #OFF : "=v"(dst) : "v"(p) : "memory")
#define ER_LOAD(g) do { const size_t off_ = (size_t)(row0 + ((g) >> 2) * HALF + ((g) & 3) * 16) * ldc + col0; const bf16_t* hp_ = hi + off_; const bf16_t* lp_ = lo + off_; \
            ER_GLD(ph[g][0], hp_, 0); ER_GLD(pl[g][0], lp_, 0); ER_GLD(ph[g][1], hp_, 256); ER_GLD(pl[g][1], lp_, 256); } while (0)
#define ER_WAIT(N, g) asm volatile("s_waitcnt vmcnt(" #N ")" : "+v"(ph[g][0]), "+v"(pl[g][0]), "+v"(ph[g][1]), "+v"(pl[g][1]) : : "memory")
#define ER_PROC(g) do { const int ai_ = (g) >> 2, m_ = (g) & 3; const int row_ = row0 + ai_ * HALF + m_ * 16; const size_t off_ = (size_t)row_ * ldc + col0; float ss_ = 0.f; \
            _Pragma("unroll") for (int bj = 0; bj < 2; ++bj) { unsigned ob_[8]; \
                _Pragma("unroll") for (int q = 0; q < 4; ++q) { const unsigned H = ph[g][bj][q], L = pl[g][bj][q]; \
                    const float x0 = __uint_as_float((H << 16) | (L & 0xffffu)), x1 = __uint_as_float((H & 0xffff0000u) | (L >> 16)); \
                    const float a0 = (q < 2) ? acc[ai_][bj][m_][0][2 * q] : acc[ai_][bj][m_][1][2 * q - 4], a1 = (q < 2) ? acc[ai_][bj][m_][0][2 * q + 1] : acc[ai_][bj][m_][1][2 * q - 3]; \
                    ob_[2 * q] = __float_as_uint(x0 + a0); ob_[2 * q + 1] = __float_as_uint(x1 + a1); } \
                _Pragma("unroll") for (int k = 0; k < 8; ++k) { const float t = __uint_as_float(ob_[k] & 0xffff0000u); ss_ += t * t; } \
                if (fin != nullptr) { f32x4 o0, o1; o0[0] = __uint_as_float(ob_[0]); o0[1] = __uint_as_float(ob_[1]); o0[2] = __uint_as_float(ob_[2]); o0[3] = __uint_as_float(ob_[3]); \
                    o1[0] = __uint_as_float(ob_[4]); o1[1] = __uint_as_float(ob_[5]); o1[2] = __uint_as_float(ob_[6]); o1[3] = __uint_as_float(ob_[7]); \
                    *(f32x4*)(fin + off_ + bj * HALF) = o0; *(f32x4*)(fin + off_ + bj * HALF + 4) = o1; } \
                else { u32x4 wh, wl; \
                    wh.x = (ob_[0] >> 16) | (ob_[1] & 0xffff0000u); wh.y = (ob_[2] >> 16) | (ob_[3] & 0xffff0000u); wh.z = (ob_[4] >> 16) | (ob_[5] & 0xffff0000u); wh.w = (ob_[6] >> 16) | (ob_[7] & 0xffff0000u); \
                    wl.x = (ob_[0] & 0xffffu) | (ob_[1] << 16); wl.y = (ob_[2] & 0xffffu) | (ob_[3] << 16); wl.z = (ob_[4] & 0xffffu) | (ob_[5] << 16); wl.w = (ob_[6] & 0xffffu) | (ob_[7] << 16); \
                    *(u32x4*)(hi + off_ + bj * HALF) = wh; *(u32x4*)(lo + off_ + bj * HALF) = wl; } } \
            ss_ += __shfl_xor(ss_, 16); ss_ += __shfl_xor(ss_, 32); \
            if (rowsq_next != nullptr && fq == 0) rowsq_next[(size_t)row_ * 16 + u.pn * 4 + wc] = ss_; } while (0)
        static_assert(HALF * 2 == 256, "bj offset in the asm loads");
        ER_LOAD(0); ER_LOAD(1); ER_LOAD(2);
        ER_WAIT(8, 0); ER_PROC(0); ER_LOAD(3); ER_WAIT(8, 1); ER_PROC(1); ER_LOAD(4); ER_WAIT(8, 2); ER_PROC(2); ER_LOAD(5); ER_WAIT(8, 3); ER_PROC(3); ER_LOAD(6);
        ER_WAIT(8, 4); ER_PROC(4); ER_LOAD(7); ER_WAIT(8, 5); ER_PROC(5); ER_WAIT(4, 6); ER_PROC(6); ER_WAIT(0, 7); ER_PROC(7);
#undef ER_GLD
#undef ER_WAIT
#undef ER_LOAD
#undef ER_PROC
    }
};
template <class Epi, class Sched, bool ALIGN_EPI = false, bool SP2 = false>
__device__ __forceinline__ void gemm_phase(PG8_LAS unsigned char* lds, const Gemm g, const Sched& S, const Epi& E) {
    int tid_ = threadIdx.x; asm volatile("" : "+v"(tid_));
    const int tid = tid_, wid = __builtin_amdgcn_readfirstlane(tid >> 6), lane = tid & 63, wr = wid >> 2, wc = wid & 3, fr = lane & 15, fq = lane >> 4;
    const int K = g.K, nt = K / BK;
    unsigned voffA[2], voffB[2];
#pragma unroll
    for (int i = 0; i < 2; ++i) { int R, C; stage_rc(tid * 16 + i * 8192, R, C); const int Rb = Epi::PERM ? ((R & ~31) + perm32(R & 31)) : R;
        voffA[i] = (unsigned)(R * K + C) * 2u; voffB[i] = (unsigned)(Rb * K + C) * 2u; }
    const size_t kstep = (size_t)(BK * 2);
    const size_t hstep = (size_t)HALF * K * 2;
    const size_t tstep = 2 * hstep;
    const unsigned ldsw = (unsigned)wid * 1024u;
    const int aoff = lds_byte(wr * 64 + fr, fq * 8), boff = lds_byte(wc * 32 + fr, fq * 8);
#define PG8_SA(b, h) (((b) * 2 + (h)) * HTB)
#define PG8_SB(b, h) ((4 + (b) * 2 + (h)) * HTB)
#define PG8_STAGE(bufoff, gbase, voff) do { _Pragma("unroll") for (int _i = 0; _i < 2; ++_i) \
        __builtin_amdgcn_global_load_lds((const unsigned*)((const char*)(gbase) + (voff)[_i]), (PG8_LAS unsigned*)(lds + (bufoff) + ldsw + _i * 8192), 16, 0, 0); } while (0)
#define PG8_LDA(dst, b, h) do { _Pragma("unroll") for (int m = 0; m < 4; ++m) _Pragma("unroll") for (int k = 0; k < 2; ++k) dst[m][k] = *(const PG8_LAS bf16x8*)(lds + PG8_SA(b, h) + aoff + m * 2048 + k * 1024); } while (0)
#define PG8_LDB(dst, b, h) do { _Pragma("unroll") for (int n = 0; n < 2; ++n) _Pragma("unroll") for (int k = 0; k < 2; ++k) dst[n][k] = *(const PG8_LAS bf16x8*)(lds + PG8_SB(b, h) + boff + n * 2048 + k * 1024); } while (0)
#define PG8_MMA(ai, bj, At, Bt) do { __builtin_amdgcn_s_setprio(1); _Pragma("unroll") for (int m = 0; m < 4; ++m) _Pragma("unroll") for (int n = 0; n < 2; ++n) _Pragma("unroll") for (int k = 0; k < 2; ++k) \
        acc[ai][bj][m][n] = __builtin_amdgcn_mfma_f32_16x16x32_bf16(Bt[n][k], At[m][k], acc[ai][bj][m][n], 0, 0, 0); __builtin_amdgcn_s_setprio(0); } while (0)
#define PG8_WAIT_V(n) asm volatile("s_waitcnt vmcnt(" #n ")" ::: "memory")
#define PG8_WAIT_L(n) asm volatile("s_waitcnt lgkmcnt(" #n ")" ::: "memory")
#define PG8_BAR __builtin_amdgcn_s_barrier()
#define PG8_SCHED __builtin_amdgcn_sched_barrier(0)
    Unit cur, nxt; int ui = 0;
    if (!S.next(0, cur)) return;
    f32x4 acc[2][2][4][2];
#pragma unroll
    for (int a = 0; a < 2; ++a)
#pragma unroll
        for (int b = 0; b < 2; ++b)
#pragma unroll
            for (int m = 0; m < 4; ++m)
#pragma unroll
                for (int n = 0; n < 2; ++n) acc[a][b][m][n] = (f32x4){0.f, 0.f, 0.f, 0.f};
    bf16x8 At[4][2], B0[2][2], B1[2][2];
    const char* cA = (const char*)g.A + (size_t)cur.pm * tstep; const char* cB = (const char*)g.Bt + (size_t)cur.pn * tstep;
    S.a_ready(cur);
    if constexpr (SP2) {
        PG8_STAGE(PG8_SB(0, 0), cB, voffB); PG8_STAGE(PG8_SB(0, 1), cB + hstep, voffB); PG8_STAGE(PG8_SA(0, 0), cA, voffA); PG8_STAGE(PG8_SA(0, 1), cA + hstep, voffA);
        if (wr == 1) PG8_BAR;
        PG8_WAIT_V(2); PG8_BAR;
        PG8_STAGE(PG8_SB(1, 0), cB + kstep, voffB); PG8_STAGE(PG8_SA(1, 0), cA + kstep, voffA); PG8_STAGE(PG8_SB(1, 1), cB + hstep + kstep, voffB);
        PG8_WAIT_V(6); PG8_BAR;
    } else {
        PG8_STAGE(PG8_SB(0, 0), cB, voffB); PG8_STAGE(PG8_SA(0, 0), cA, voffA); PG8_STAGE(PG8_SB(0, 1), cB + hstep, voffB); PG8_STAGE(PG8_SA(0, 1), cA + hstep, voffA);
        if (wr == 1) PG8_BAR;
        PG8_WAIT_V(4); PG8_BAR;
        PG8_STAGE(PG8_SB(1, 0), cB + kstep, voffB); PG8_STAGE(PG8_SA(1, 0), cA + kstep, voffA); PG8_STAGE(PG8_SB(1, 1), cB + hstep + kstep, voffB);
        PG8_WAIT_V(6); PG8_BAR;
    }
    for (;;) {
        const bool has_next = S.next(ui + 1, nxt);
        const char* nA = has_next ? (const char*)g.A + (size_t)nxt.pm * tstep : cA; const char* nB = has_next ? (const char*)g.Bt + (size_t)nxt.pn * tstep : cB;
        for (int t = 0; t < nt; t += 2) {
            const bool last = (t == nt - 2);
            const char* a1 = cA + (size_t)(t + 1) * kstep;
            const char* a2 = last ? nA : cA + (size_t)(t + 2) * kstep; const char* b2 = last ? nB : cB + (size_t)(t + 2) * kstep;
            const char* a3 = a2 + kstep; const char* b3 = b2 + kstep;
            if (last && has_next) S.a_ready(nxt);
            if constexpr (SP2) {
            PG8_LDB(B0, 0, 0); PG8_LDB(B1, 0, 1); PG8_SCHED; PG8_LDA(At, 0, 0); PG8_STAGE(PG8_SA(1, 1), a1 + hstep, voffA);
            PG8_WAIT_V(8); PG8_WAIT_L(0); PG8_BAR; PG8_MMA(0, 0, At, B0); PG8_MMA(0, 1, At, B1); PG8_BAR; PG8_SCHED;
            PG8_LDA(At, 0, 1); PG8_STAGE(PG8_SB(0, 0), b2, voffB); PG8_STAGE(PG8_SB(0, 1), b2 + hstep, voffB); PG8_STAGE(PG8_SA(0, 0), a2, voffA);
            PG8_WAIT_V(8); PG8_WAIT_L(0); PG8_BAR; PG8_MMA(1, 0, At, B0); PG8_MMA(1, 1, At, B1); PG8_BAR; PG8_SCHED;
            PG8_LDB(B0, 1, 0); PG8_LDB(B1, 1, 1); PG8_SCHED; PG8_LDA(At, 1, 0); PG8_STAGE(PG8_SA(0, 1), a2 + hstep, voffA);
            PG8_WAIT_V(8); PG8_WAIT_L(0); PG8_BAR; PG8_MMA(0, 0, At, B0); PG8_MMA(0, 1, At, B1); PG8_BAR; PG8_SCHED;
            PG8_LDA(At, 1, 1); PG8_STAGE(PG8_SB(1, 0), b3, voffB); PG8_STAGE(PG8_SB(1, 1), b3 + hstep, voffB); PG8_STAGE(PG8_SA(1, 0), a3, voffA);
            PG8_WAIT_V(8); PG8_WAIT_L(0); PG8_BAR; PG8_MMA(1, 0, At, B0); PG8_MMA(1, 1, At, B1); PG8_BAR; PG8_SCHED;
            } else {
            PG8_LDB(B0, 0, 0); PG8_SCHED; PG8_LDA(At, 0, 0); PG8_STAGE(PG8_SA(1, 1), a1 + hstep, voffA);
            PG8_WAIT_L(8); PG8_BAR; PG8_WAIT_L(0); PG8_MMA(0, 0, At, B0); PG8_BAR; PG8_SCHED;
            PG8_LDB(B1, 0, 1); PG8_STAGE(PG8_SB(0, 0), b2, voffB);
            PG8_BAR; PG8_WAIT_L(0); PG8_MMA(0, 1, At, B1); PG8_BAR;
            PG8_LDA(At, 0, 1); PG8_STAGE(PG8_SA(0, 0), a2, voffA);
            PG8_BAR; PG8_WAIT_L(0); PG8_MMA(1, 0, At, B0); PG8_BAR; PG8_SCHED;
            PG8_STAGE(PG8_SB(0, 1), b2 + hstep, voffB);
            PG8_WAIT_V(6); PG8_BAR; PG8_MMA(1, 1, At, B1); PG8_BAR;
            PG8_LDB(B0, 1, 0); PG8_SCHED; PG8_LDA(At, 1, 0); PG8_STAGE(PG8_SA(0, 1), a2 + hstep, voffA);
            PG8_WAIT_L(8); PG8_BAR; PG8_WAIT_L(0); PG8_MMA(0, 0, At, B0); PG8_BAR; PG8_SCHED;
            PG8_LDB(B1, 1, 1); PG8_STAGE(PG8_SB(1, 0), b3, voffB);
            PG8_BAR; PG8_WAIT_L(0); PG8_MMA(0, 1, At, B1); PG8_BAR;
            PG8_LDA(At, 1, 1); PG8_STAGE(PG8_SA(1, 0), a3, voffA);
            PG8_BAR; PG8_WAIT_L(0); PG8_MMA(1, 0, At, B0); PG8_BAR; PG8_SCHED;
            PG8_STAGE(PG8_SB(1, 1), b3 + hstep, voffB);
            PG8_WAIT_V(6); PG8_BAR; PG8_MMA(1, 1, At, B1); PG8_BAR;
            }
        }
        if constexpr (ALIGN_EPI) { if (wr == 0) PG8_BAR; }
        if constexpr (!Epi::AFTER_DRAIN) { E(acc, cur, wr, wc, fr, fq); S.done(cur); }
        if (!has_next) break;
#pragma unroll
        for (int a = 0; a < 2; ++a)
#pragma unroll
            for (int b = 0; b < 2; ++b)
#pragma unroll
                for (int m = 0; m < 4; ++m)
#pragma unroll
                    for (int n = 0; n < 2; ++n) acc[a][b][m][n] = (f32x4){0.f, 0.f, 0.f, 0.f};
        cur = nxt; cA = nA; cB = nB; ++ui;
        if constexpr (ALIGN_EPI) { if (wr == 1) PG8_BAR; }
    }
    PG8_WAIT_V(0);
    if constexpr (!ALIGN_EPI) { if (wr == 0) PG8_BAR; }
    PG8_BAR;
    if constexpr (Epi::AFTER_DRAIN) { E.fused(acc, cur, wr, wc, fr, fq, lds, wid, lane); S.done(cur); }
#undef PG8_SA
#undef PG8_SB
#undef PG8_STAGE
#undef PG8_LDA
#undef PG8_LDB
#undef PG8_MMA
#undef PG8_WAIT_V
#undef PG8_WAIT_L
#undef PG8_BAR
#undef PG8_SCHED
}
}

constexpr int BATCH = 8, SEQ = 4096, DM = 1024, DEPTH = 4, DFF = 4096;
constexpr int M_TOK = BATCH * SEQ;
constexpr int EVEN_IN = 3072, ODD_IN = 1536;
constexpr int NWAVES = 8, NTHREADS = 512;
constexpr int LDS_BYTES = 157696;
constexpr int N_PHASES = 1 + 7 * DEPTH;

constexpr size_t MiB = 1u << 20;
constexpr size_t WS_ROWSQ = 420 * MiB;
constexpr size_t WS_BAR = 1 * MiB;
constexpr size_t WS_WMLP_IN = 2 * MiB;
constexpr size_t WS_WMLP_OUT = 34 * MiB;
constexpr size_t WS_WIN_EVEN = 66 * MiB;
constexpr size_t WS_WOUT_EVEN = 78 * MiB;
constexpr size_t WS_WIN_ODD = 82 * MiB;
constexpr size_t WS_WOUT_ODD = 88 * MiB;
constexpr size_t WS_COS = 92 * MiB, WS_SIN = 96 * MiB;
constexpr size_t WS_XB = 100 * MiB;
constexpr size_t WS_Z = 164 * MiB;
constexpr size_t WS_Y = 356 * MiB;
constexpr size_t WS_HID = 164 * MiB;
constexpr size_t WS_LO = 436 * MiB;
constexpr size_t OUT_HU = 0, OUT_HQT = 64 * MiB, OUT_HOI = 96 * MiB;
constexpr size_t WS_HDL = 500 * MiB;
constexpr size_t WS_END = 501 * MiB;

typedef unsigned short bf16_t;
typedef short bf16x8 __attribute__((ext_vector_type(8)));
typedef float f32x4 __attribute__((ext_vector_type(4)));
typedef unsigned u32x4 __attribute__((ext_vector_type(4)));
typedef unsigned u32x2 __attribute__((ext_vector_type(2)));
#define LAS __attribute__((address_space(3)))
#define MFMA16(a, b, c) __builtin_amdgcn_mfma_f32_16x16x32_bf16((a), (b), (c), 0, 0, 0)

__device__ __forceinline__ float bf2f(unsigned u) { return __uint_as_float(u << 16); }
__device__ __forceinline__ float bflo(unsigned u) { return __uint_as_float(u << 16); }
__device__ __forceinline__ float bfhi(unsigned u) { return __uint_as_float(u & 0xffff0000u); }
__device__ __forceinline__ unsigned f2bf(float f) { unsigned u = __float_as_uint(f); return (u + 0x7fffu + ((u >> 16) & 1u)) >> 16; }
__device__ __forceinline__ unsigned pk2(float lo, float hi) { return f2bf(lo) | (f2bf(hi) << 16); }
__device__ __forceinline__ float wave_sum(float v) {
#pragma unroll
    for (int o = 1; o < 64; o <<= 1) v += __shfl_xor(v, o);
    return v;
}
__device__ __forceinline__ float red16_sum(float v) { v += __shfl_xor(v, 1); v += __shfl_xor(v, 2); v += __shfl_xor(v, 4); v += __shfl_xor(v, 8); return v; }
__device__ __forceinline__ float red16_max(float v) { v = fmaxf(v, __shfl_xor(v, 1)); v = fmaxf(v, __shfl_xor(v, 2)); v = fmaxf(v, __shfl_xor(v, 4)); v = fmaxf(v, __shfl_xor(v, 8)); return v; }
__device__ __forceinline__ bf16x8 ldfrag(const bf16_t* p) { return *(const bf16x8*)p; }

struct Args {
    const float* in[22]; const int* pos; float* out; unsigned char* ws; int ph_lo, ph_hi;
};

__device__ __forceinline__ void p0_transpose_item(const float* W, int K, int N, bf16_t* WT, const float* gain, float* scr, int item, int lane) {
    const int nblk = N / 64, kb = item / nblk, nb = item % nblk, k0 = 64 * kb, n0 = 64 * nb;
    const int c4 = (lane & 15) * 4;
#pragma unroll 8
    for (int i = 0; i < 16; ++i) { const int kk = 4 * i + (lane >> 4); const float g = gain ? gain[k0 + kk] : 1.0f;
        const f32x4 v = *(const f32x4*)(W + (size_t)(k0 + kk) * N + n0 + c4);
        float* d = scr + kk * 65 + c4; d[0] = v[0] * g; d[1] = v[1] * g; d[2] = v[2] * g; d[3] = v[3] * g; }
    asm volatile("s_waitcnt lgkmcnt(0)" ::: "memory");
    const int c = lane & 7;
#pragma unroll
    for (int j = 0; j < 8; ++j) { const int n = (lane >> 3) + 8 * j; const float* s = scr + (8 * c) * 65 + n;
        u32x4 o; o.x = pk2(s[0 * 65], s[1 * 65]); o.y = pk2(s[2 * 65], s[3 * 65]); o.z = pk2(s[4 * 65], s[5 * 65]); o.w = pk2(s[6 * 65], s[7 * 65]);
        *(u32x4*)(WT + (size_t)(n0 + n) * K + k0 + 8 * c) = o; }
    asm volatile("s_waitcnt lgkmcnt(0)" ::: "memory");
}

__device__ __forceinline__ void p0_prologue(const Args& a, unsigned char* lds) {
    int tid_ = threadIdx.x; asm volatile("" : "+v"(tid_));
    const int tid = tid_, lane = tid & 63, wave = tid >> 6;
    const int G = gridDim.x, bid = blockIdx.x;
    const int gw = bid * NWAVES + wave, NGW = G * NWAVES;
    const int gt = bid * NTHREADS + tid, NGT = G * NTHREADS;
    unsigned char* ws = a.ws;
    float* scr = (float*)(lds + wave * 17408);
    const float* norm_mix = a.in[2]; const float* norm_mlp = a.in[3];
    constexpr int NITEMS = 4 * 2048 + 2 * 1024 + 2 * 640;
    for (int it0 = gw; it0 < NITEMS; it0 += NGW) {
        int it = it0;
        if (it < 8192) { const int l = it >> 11, r = it & 2047;
            if (r < 1024) p0_transpose_item(a.in[4] + (size_t)l * DM * DFF, DM, DFF, (bf16_t*)(ws + WS_WMLP_IN) + (size_t)l * DM * DFF, norm_mlp + l * DM, scr, r, lane);
            else p0_transpose_item(a.in[5] + (size_t)l * DM * DFF, DFF, DM, (bf16_t*)(ws + WS_WMLP_OUT) + (size_t)l * DM * DFF, nullptr, scr, r - 1024, lane);
            continue; }
        it -= 8192;
        if (it < 2048) { const int e = it >> 10, r = it & 1023;
            if (r < 768) p0_transpose_item(a.in[6] + (size_t)e * DM * EVEN_IN, DM, EVEN_IN, (bf16_t*)(ws + WS_WIN_EVEN) + (size_t)e * DM * EVEN_IN, norm_mix + (2 * e) * DM, scr, r, lane);
            else p0_transpose_item(a.in[7] + (size_t)e * DM * DM, DM, DM, (bf16_t*)(ws + WS_WOUT_EVEN) + (size_t)e * DM * DM, nullptr, scr, r - 768, lane);
            continue; }
        it -= 2048;
        { const int o = it / 640, r = it % 640;
            if (r < 384) p0_transpose_item(a.in[17] + (size_t)o * DM * ODD_IN, DM, ODD_IN, (bf16_t*)(ws + WS_WIN_ODD) + (size_t)o * DM * ODD_IN, norm_mix + (2 * o + 1) * DM, scr, r, lane);
            else p0_transpose_item(a.in[18] + (size_t)o * DM * DM, DM, DM, (bf16_t*)(ws + WS_WOUT_ODD) + (size_t)o * DM * DM, nullptr, scr, r - 384, lane); }
    }
    { const float* x = a.in[0]; bf16_t* xb = (bf16_t*)(ws + WS_XB); bf16_t* xl = (bf16_t*)(ws + WS_LO); float* rq0 = (float*)(ws + WS_ROWSQ);
      const bool xa = (G == 256);
      for (int m = xa ? ((bid & 7) * 4096 + 2 * ((bid >> 3) * 8 + wave)) : 2 * gw; m < (xa ? (bid & 7) * 4096 + 4096 : M_TOK); m += (xa ? 512 : 2 * NGW)) {
          const u32x4* xr = (const u32x4*)(x + (size_t)m * DM) + lane; u32x2* oh = (u32x2*)(xb + (size_t)m * DM) + lane; u32x2* ol = (u32x2*)(xl + (size_t)m * DM) + lane;
          u32x4 v[8];
#pragma unroll
          for (int j = 0; j < 8; ++j) v[j] = xr[64 * j];
          float s0 = 0.f, s1 = 0.f;
#pragma unroll
          for (int j = 0; j < 8; ++j) { const float t0 = __uint_as_float(v[j][0] & 0xffff0000u), t1 = __uint_as_float(v[j][1] & 0xffff0000u), t2 = __uint_as_float(v[j][2] & 0xffff0000u), t3 = __uint_as_float(v[j][3] & 0xffff0000u);
              const float q = (t0 * t0 + t1 * t1) + (t2 * t2 + t3 * t3); if (j < 4) s0 += q; else s1 += q;
              u32x2 wh, wl; wh.x = (v[j][0] >> 16) | (v[j][1] & 0xffff0000u); wh.y = (v[j][2] >> 16) | (v[j][3] & 0xffff0000u);
              wl.x = (v[j][0] & 0xffffu) | (v[j][1] << 16); wl.y = (v[j][2] & 0xffffu) | (v[j][3] << 16); oh[64 * j] = wh; ol[64 * j] = wl; }
          s0 = wave_sum(s0); s1 = wave_sum(s1);
          if (lane < 32) rq0[(size_t)m * 16 + lane] = (lane == 0) ? s0 : ((lane == 16) ? s1 : 0.f); } }
    { float* cs = (float*)(ws + WS_COS); float* sn = (float*)(ws + WS_SIN);
      for (int i = gt; i < M_TOK * 32; i += NGT) { const int tok = i >> 5, j = i & 31;
          const float invf = exp2f(-(float)j * (13.287712379549449f / 32.0f));
          const float ang = (float)a.pos[tok] * invf;
          double rev = (double)ang * 0.15915494309189535; rev -= rint(rev);
          const float fr = (float)rev;
          sn[i] = __builtin_amdgcn_sinf(fr); cs[i] = __builtin_amdgcn_cosf(fr); } }
}

#define LBAR() asm volatile("s_waitcnt lgkmcnt(0)\n\ts_barrier" ::: "memory")
typedef float f32x2_t __attribute__((ext_vector_type(2))); typedef __bf16 bf16x2_t __attribute__((ext_vector_type(2)));
__device__ __forceinline__ unsigned cvtpk(float lo, float hi) { f32x2_t v = {lo, hi}; bf16x2_t b = __builtin_convertvector(v, bf16x2_t); return __builtin_bit_cast(unsigned, b); }
__device__ __forceinline__ bf16_t cvt1(float v) { return (bf16_t)(cvtpk(v, 0.f) & 0xffffu); }
__device__ __forceinline__ void hgrn_s1(unsigned char* lds, int it0, int step, int iend, const bf16_t* z, unsigned char* ws, unsigned char* hb, const float* lb_logits, int e_layer) {
    int tid_ = threadIdx.x; asm volatile("" : "+v"(tid_));
    const int tid = tid_, lane = tid & 63, w = tid >> 6, l15 = lane & 15, lg = lane >> 4;
    bf16_t* Qm = (bf16_t*)(lds + 0);
    bf16_t* Km = (bf16_t*)(lds + 17408);
    bf16_t* Qt = (bf16_t*)(lds + 34816);
    bf16_t* KdT = (bf16_t*)(lds + 52224);
    bf16_t* vT = (bf16_t*)(lds + 70656);
    bf16_t* P = (bf16_t*)(lds + 123904);
    float* segtot = (float*)(lds + 133120);
    bf16_t* QT = (bf16_t*)(hb + OUT_HQT); bf16_t* HU = (bf16_t*)(hb + OUT_HU); bf16_t* OI = (bf16_t*)(hb + OUT_HOI); float* DL = (float*)(ws + WS_HDL);
    const int tt = w >> 1, eh = w & 1;
    u32x4 rq[2], rf[2], rv[2];
    int it = it0;
    if (it < iend) { const size_t row0 = (size_t)(it >> 8) * SEQ + 64 * (it & 63); const int h = (it >> 6) & 3;
#pragma unroll
        for (int i = 0; i < 2; ++i) { const int idx = tid + 512 * i, r = idx >> 4, ch = idx & 15; const bf16_t* p = z + (row0 + r) * EVEN_IN + h * 128 + ch * 8;
            rq[i] = *(const u32x4*)p; rf[i] = *(const u32x4*)(p + 512);
            const int rv_r = idx & 63, rv_ch = idx >> 6; rv[i] = *(const u32x4*)(z + (row0 + rv_r) * EVEN_IN + 1024 + h * 128 + rv_ch * 8); } }
    for (; it < iend; it += step) {
        const int h = (it >> 6) & 3;
        const int c0 = h * 128 + 2 * lane;
        float lb0 = 0.f, lb1 = 0.f;
        if (e_layer == 1) { lb0 = 1.0f / (1.0f + __expf(lb_logits[c0] - lb_logits[512 + c0])); lb1 = 1.0f / (1.0f + __expf(lb_logits[c0 + 1] - lb_logits[512 + c0 + 1])); }
        const float om0 = 1.0f - lb0, om1 = 1.0f - lb1;
#pragma unroll
        for (int i = 0; i < 2; ++i) { const int idx = tid + 512 * i, r = idx >> 4, ch = idx & 15;
            *(u32x4*)(Qm + r * 136 + ch * 8) = rq[i]; *(u32x4*)(Km + r * 136 + ch * 8) = rf[i];
            const int vr = idx & 63, vch = idx >> 6; const u32x4 v = rv[i];
            vT[(vch * 8 + 0) * 72 + vr] = (bf16_t)(v.x & 0xffffu); vT[(vch * 8 + 1) * 72 + vr] = (bf16_t)(v.x >> 16);
            vT[(vch * 8 + 2) * 72 + vr] = (bf16_t)(v.y & 0xffffu); vT[(vch * 8 + 3) * 72 + vr] = (bf16_t)(v.y >> 16);
            vT[(vch * 8 + 4) * 72 + vr] = (bf16_t)(v.z & 0xffffu); vT[(vch * 8 + 5) * 72 + vr] = (bf16_t)(v.z >> 16);
            vT[(vch * 8 + 6) * 72 + vr] = (bf16_t)(v.w & 0xffffu); vT[(vch * 8 + 7) * 72 + vr] = (bf16_t)(v.w >> 16); }
        if (it + step < iend) { const int nx = it + step; const size_t row0 = (size_t)(nx >> 8) * SEQ + 64 * (nx & 63); const int hn = (nx >> 6) & 3;
#pragma unroll
            for (int i = 0; i < 2; ++i) { const int idx = tid + 512 * i, r = idx >> 4, ch = idx & 15; const bf16_t* p = z + (row0 + r) * EVEN_IN + hn * 128 + ch * 8;
                rq[i] = *(const u32x4*)p; rf[i] = *(const u32x4*)(p + 512);
                const int rv_r = idx & 63, rv_ch = idx >> 6; rv[i] = *(const u32x4*)(z + (row0 + rv_r) * EVEN_IN + 1024 + hn * 128 + rv_ch * 8); } }
        LBAR();
        float kk0[8], kk1[8], bl0[8], bl1[8]; float cum0 = 0.f, cum1 = 0.f;
#pragma unroll
        for (int i = 0; i < 8; ++i) { const int t = 8 * w + i; const unsigned fx2 = *(const unsigned*)(Km + t * 136 + 2 * lane);
            const float fx0 = bflo(fx2), fx1 = bfhi(fx2);
            const float e0 = __expf(-fx0), e1 = __expf(-fx1); const float s0 = __builtin_amdgcn_rcpf(1.0f + e0), s1 = __builtin_amdgcn_rcpf(1.0f + e1);
            const float f0 = lb0 + om0 * s0, f1 = lb1 + om1 * s1;
            cum0 += __logf(fmaxf(f0, 1e-30f)); cum1 += __logf(fmaxf(f1, 1e-30f));
            bl0[i] = cum0; bl1[i] = cum1; kk0[i] = om0 * e0 * s0; kk1[i] = om1 * e1 * s1; }
        segtot[w * 128 + 2 * lane] = cum0; segtot[w * 128 + 2 * lane + 1] = cum1;
        LBAR();
        float off0 = 0.f, off1 = 0.f, mid0 = 0.f, mid1 = 0.f, la0 = 0.f, la1 = 0.f;
#pragma unroll
        for (int s = 0; s < 8; ++s) { const float a0 = segtot[s * 128 + 2 * lane], a1 = segtot[s * 128 + 2 * lane + 1];
            if (s < w) { off0 += a0; off1 += a1; } if (s < 4) { mid0 += a0; mid1 += a1; } la0 += a0; la1 += a1; }
        const float em0 = __expf(mid0), em1 = __expf(mid1), elm0 = __expf(la0 - mid0), elm1 = __expf(la1 - mid1);
        unsigned kd0[4], kd1[4]; float kdprev0 = 0.f, kdprev1 = 0.f;
#pragma unroll
        for (int i = 0; i < 8; ++i) { const int t = 8 * w + i; const unsigned q2 = *(const unsigned*)(Qm + t * 136 + 2 * lane);
            const float q0 = bflo(q2), q1 = bfhi(q2); const float b0 = off0 + bl0[i], b1 = off1 + bl1[i];
            const float qm0 = q0 * __expf(fminf(b0 - mid0, 80.f)), qm1 = q1 * __expf(fminf(b1 - mid1, 80.f));
            const float km0 = kk0[i] * __expf(fminf(mid0 - b0, 80.f)), km1 = kk1[i] * __expf(fminf(mid1 - b1, 80.f));
            const float qt0 = qm0 * em0, qt1 = qm1 * em1;
            const float kdv0 = km0 * elm0, kdv1 = km1 * elm1;
            *(unsigned*)(Qm + t * 136 + 2 * lane) = cvtpk(qm0, qm1); *(unsigned*)(Km + t * 136 + 2 * lane) = cvtpk(km0, km1); *(unsigned*)(Qt + t * 136 + 2 * lane) = cvtpk(qt0, qt1);
            if (i & 1) { kd0[i >> 1] = cvtpk(kdprev0, kdv0); kd1[i >> 1] = cvtpk(kdprev1, kdv1); } else { kdprev0 = kdv0; kdprev1 = kdv1; } }
        { u32x4 t0; t0.x = kd0[0]; t0.y = kd0[1]; t0.z = kd0[2]; t0.w = kd0[3]; *(u32x4*)(KdT + (2 * lane) * 72 + 8 * w) = t0;
          u32x4 t1; t1.x = kd1[0]; t1.y = kd1[1]; t1.z = kd1[2]; t1.w = kd1[3]; *(u32x4*)(KdT + (2 * lane + 1) * 72 + 8 * w) = t1; }
        if (w == 0) { f32x2_t dv = {em0 * elm0, em1 * elm1}; *(f32x2_t*)(DL + (size_t)it * 128 + 2 * lane) = dv; }
        LBAR();
#pragma unroll
        for (int sti = 0; sti < 2; ++sti) { const int st = 2 * eh + sti; f32x4 acc = (f32x4){0.f, 0.f, 0.f, 0.f};
            if (st <= tt) {
#pragma unroll
                for (int ks = 0; ks < 4; ++ks) acc = MFMA16(ldfrag(Qm + (16 * tt + l15) * 136 + 32 * ks + 8 * lg), ldfrag(Km + (16 * st + l15) * 136 + 32 * ks + 8 * lg), acc); }
#pragma unroll
            for (int reg = 0; reg < 4; ++reg) { const int t = 16 * tt + 4 * lg + reg, s = 16 * st + l15; const float v = (st <= tt && s <= t) ? acc[reg] : 0.f; P[t * 72 + s] = cvt1(v); } }
        { const bf16x8 a0 = ldfrag(KdT + (16 * w + l15) * 72 + 8 * lg), a1 = ldfrag(KdT + (16 * w + l15) * 72 + 32 + 8 * lg);
#pragma unroll
          for (int j = 0; j < 8; ++j) { f32x4 sv = (f32x4){0.f, 0.f, 0.f, 0.f};
              sv = MFMA16(a0, ldfrag(vT + (16 * j + l15) * 72 + 8 * lg), sv); sv = MFMA16(a1, ldfrag(vT + (16 * j + l15) * 72 + 32 + 8 * lg), sv);
              u32x2 pk; pk.x = cvtpk(sv[0], sv[1]); pk.y = cvtpk(sv[2], sv[3]); *(u32x2*)(HU + (((size_t)it * 8 + w) * 8 + j) * 256 + lane * 4) = pk; } }
#pragma unroll
        for (int i = 0; i < 2; ++i) { const int idx = tid + 512 * i, r = idx >> 4, ch = idx & 15; *(u32x4*)(QT + (size_t)it * 8192 + r * 128 + ch * 8) = *(const u32x4*)(Qt + r * 136 + ch * 8); }
        LBAR();
        { bf16x8 pa[2];
#pragma unroll
          for (int ks = 0; ks < 2; ++ks) pa[ks] = ldfrag(P + (16 * tt + l15) * 72 + 32 * ks + 8 * lg);
#pragma unroll
          for (int j = 0; j < 4; ++j) { const int et = 4 * eh + j; f32x4 acc = (f32x4){0.f, 0.f, 0.f, 0.f};
#pragma unroll
              for (int ks = 0; ks < 2; ++ks) acc = MFMA16(pa[ks], ldfrag(vT + (16 * et + l15) * 72 + 32 * ks + 8 * lg), acc);
              u32x2 pk; pk.x = cvtpk(acc[0], acc[1]); pk.y = cvtpk(acc[2], acc[3]); *(u32x2*)(OI + (((size_t)it * 4 + tt) * 8 + et) * 256 + lane * 4) = pk; } }
        LBAR();
    }
    __syncthreads();
}

struct HgrnSet { u32x4 q[2]; u32x2 u[2]; u32x2 oi; f32x4 dl; };
__device__ __forceinline__ void hgrn_s2_load(HgrnSet& s, int it, const unsigned char* ws, const unsigned char* hb, int tid, int lane, int w, int lg, int tt, int et, int eq) {
    const bf16_t* QT = (const bf16_t*)(hb + OUT_HQT); const bf16_t* HU = (const bf16_t*)(hb + OUT_HU); const bf16_t* OI = (const bf16_t*)(hb + OUT_HOI); const float* DL = (const float*)(ws + WS_HDL);
#pragma unroll
    for (int i = 0; i < 2; ++i) { const int idx = tid + 512 * i, r = idx >> 4, ch = idx & 15; s.q[i] = *(const u32x4*)(QT + (size_t)it * 8192 + r * 128 + ch * 8); }
#pragma unroll
    for (int jj = 0; jj < 2; ++jj) s.u[jj] = *(const u32x2*)(HU + (((size_t)it * 8 + w) * 8 + 2 * eq + jj) * 256 + lane * 4);
    s.oi = *(const u32x2*)(OI + (((size_t)it * 4 + tt) * 8 + 2 * eq + et) * 256 + lane * 4);
    s.dl = *(const f32x4*)(DL + (size_t)it * 128 + 16 * w + 4 * lg);
}
__device__ __forceinline__ void hgrn_s2_chunk(HgrnSet& s, f32x4 (&S)[2], int it, bool more, unsigned char* lds, const unsigned char* ws, const unsigned char* hb, bf16_t* yrow, int tid, int lane, int w, int l15, int lg, int tt, int et, int eq) {
    bf16_t* Qts = (bf16_t*)(lds + 0);
    bf16_t* ST2 = (bf16_t*)(lds + 17408);
    bf16_t* O2s = (bf16_t*)(lds + 26112);
#pragma unroll
    for (int i = 0; i < 2; ++i) { const int idx = tid + 512 * i, r = idx >> 4, ch = idx & 15; *(u32x4*)(Qts + r * 136 + ch * 8) = s.q[i]; }
#pragma unroll
    for (int jj = 0; jj < 2; ++jj) { u32x2 pk; pk.x = cvtpk(S[jj][0], S[jj][1]); pk.y = cvtpk(S[jj][2], S[jj][3]); *(u32x2*)(ST2 + (16 * jj + l15) * 136 + 16 * w + 4 * lg) = pk; }
    const u32x2 u0 = s.u[0], u1 = s.u[1], oi = s.oi; const f32x4 dl = s.dl;
    if (more) hgrn_s2_load(s, it + 4, ws, hb, tid, lane, w, lg, tt, et, eq);
    LBAR();
    f32x4 acc = (f32x4){0.f, 0.f, 0.f, 0.f};
#pragma unroll
    for (int ks = 0; ks < 4; ++ks) acc = MFMA16(ldfrag(Qts + (16 * tt + l15) * 136 + 32 * ks + 8 * lg), ldfrag(ST2 + (16 * et + l15) * 136 + 32 * ks + 8 * lg), acc);
    const float o0 = acc[0] + bflo(oi.x), o1 = acc[1] + bfhi(oi.x), o2 = acc[2] + bflo(oi.y), o3 = acc[3] + bfhi(oi.y);
    O2s[(16 * tt + 4 * lg + 0) * 40 + 16 * et + l15] = cvt1(o0); O2s[(16 * tt + 4 * lg + 1) * 40 + 16 * et + l15] = cvt1(o1);
    O2s[(16 * tt + 4 * lg + 2) * 40 + 16 * et + l15] = cvt1(o2); O2s[(16 * tt + 4 * lg + 3) * 40 + 16 * et + l15] = cvt1(o3);
    S[0][0] = dl[0] * S[0][0] + bflo(u0.x); S[0][1] = dl[1] * S[0][1] + bfhi(u0.x); S[0][2] = dl[2] * S[0][2] + bflo(u0.y); S[0][3] = dl[3] * S[0][3] + bfhi(u0.y);
    S[1][0] = dl[0] * S[1][0] + bflo(u1.x); S[1][1] = dl[1] * S[1][1] + bfhi(u1.x); S[1][2] = dl[2] * S[1][2] + bflo(u1.y); S[1][3] = dl[3] * S[1][3] + bfhi(u1.y);
    LBAR();
    if (tid < 256) { const int r = tid >> 2, ch = tid & 3; *(u32x4*)(yrow + (size_t)r * DM + ch * 8) = *(const u32x4*)(O2s + r * 40 + ch * 8); }
}
__device__ __forceinline__ void hgrn_s2(unsigned char* lds, int blk, const unsigned char* ws, const unsigned char* hb, bf16_t* y) {
    int tid_ = threadIdx.x; asm volatile("" : "+v"(tid_));
    const int tid = tid_, lane = tid & 63, w = tid >> 6, l15 = lane & 15, lg = lane >> 4;
    const int b = blk >> 4, h = (blk >> 2) & 3, eq = blk & 3, tt = w >> 1, et = w & 1;
    const int it0 = (b * 4 + h) * 64;
    f32x4 S[2]; S[0] = (f32x4){0.f, 0.f, 0.f, 0.f}; S[1] = (f32x4){0.f, 0.f, 0.f, 0.f};
    HgrnSet s0, s1, s2, s3;
    hgrn_s2_load(s0, it0 + 0, ws, hb, tid, lane, w, lg, tt, et, eq); hgrn_s2_load(s1, it0 + 1, ws, hb, tid, lane, w, lg, tt, et, eq);
    hgrn_s2_load(s2, it0 + 2, ws, hb, tid, lane, w, lg, tt, et, eq); hgrn_s2_load(s3, it0 + 3, ws, hb, tid, lane, w, lg, tt, et, eq);
    bf16_t* ybase = y + ((size_t)b * SEQ) * DM + h * 128 + 32 * eq;
    for (int c = 0; c < 64; c += 4) {
        const bool more = (c + 4 < 64);
        hgrn_s2_chunk(s0, S, it0 + c + 0, more, lds, ws, hb, ybase + (size_t)(64 * (c + 0)) * DM, tid, lane, w, l15, lg, tt, et, eq);
        hgrn_s2_chunk(s1, S, it0 + c + 1, more, lds, ws, hb, ybase + (size_t)(64 * (c + 1)) * DM, tid, lane, w, l15, lg, tt, et, eq);
        hgrn_s2_chunk(s2, S, it0 + c + 2, more, lds, ws, hb, ybase + (size_t)(64 * (c + 2)) * DM, tid, lane, w, l15, lg, tt, et, eq);
        hgrn_s2_chunk(s3, S, it0 + c + 3, more, lds, ws, hb, ybase + (size_t)(64 * (c + 3)) * DM, tid, lane, w, l15, lg, tt, et, eq);
    }
    __syncthreads();
}

__device__ __forceinline__ void hgrn_s3(int G, int bid, const bf16_t* z, bf16_t* y, const float* gn) {
    int tid_ = threadIdx.x; asm volatile("" : "+v"(tid_));
    const int tid = tid_, lane = tid & 63, wave = tid >> 6;
    const int gw = bid * NWAVES + wave, NGW = G * NWAVES;
    const f32x4 g0 = *(const f32x4*)(gn + lane * 8), g1 = *(const f32x4*)(gn + lane * 8 + 4);
    const bool xa = (G == 256);
    for (int row = xa ? ((bid & 7) * 4096 + (bid >> 3) * 8 + wave) : gw; row < (xa ? (bid & 7) * 4096 + 4096 : M_TOK); row += (xa ? 256 : NGW)) {
        const u32x4 ov = *(const u32x4*)(y + (size_t)row * DM + lane * 8); const u32x4 gv = *(const u32x4*)(z + (size_t)row * EVEN_IN + 1536 + lane * 8);
        float o[8], ga[8];
        o[0] = bflo(ov.x); o[1] = bfhi(ov.x); o[2] = bflo(ov.y); o[3] = bfhi(ov.y); o[4] = bflo(ov.z); o[5] = bfhi(ov.z); o[6] = bflo(ov.w); o[7] = bfhi(ov.w);
        ga[0] = bflo(gv.x); ga[1] = bfhi(gv.x); ga[2] = bflo(gv.y); ga[3] = bfhi(gv.y); ga[4] = bflo(gv.z); ga[5] = bfhi(gv.z); ga[6] = bflo(gv.w); ga[7] = bfhi(gv.w);
        float ss = 0.f;
#pragma unroll
        for (int k = 0; k < 8; ++k) ss += o[k] * o[k];
        ss = red16_sum(ss);
        const float rs = rsqrtf(ss * (1.0f / 128.0f) + 1e-6f);
        float r[8];
#pragma unroll
        for (int k = 0; k < 8; ++k) { const float gk = (k < 4) ? g0[k & 3] : g1[k & 3]; r[k] = o[k] * rs * gk * (ga[k] * __builtin_amdgcn_rcpf(1.0f + __expf(-ga[k]))); }
        u32x4 wv; wv.x = cvtpk(r[0], r[1]); wv.y = cvtpk(r[2], r[3]); wv.z = cvtpk(r[4], r[5]); wv.w = cvtpk(r[6], r[7]);
        *(u32x4*)(y + (size_t)row * DM + lane * 8) = wv;
    }
}

__device__ __forceinline__ void rglru_item(unsigned char* lds, int b, int n, int jq, const bf16_t* z, bf16_t* y, const float* conv_w, const float* conv_b,
                                           const float* wa, const float* ba, const float* wx, const float* bx, const float* lam) {
    int tid_ = threadIdx.x; asm volatile("" : "+v"(tid_));
    const int tid = tid_, lane = tid & 63, w = tid >> 6, l15 = lane & 15, lg = lane >> 4;
    bf16_t* raw = (bf16_t*)(lds);
    bf16_t* Wt = (bf16_t*)(lds + 37440);
    float* G = (float*)(lds + 55872);
    float* AH = (float*)(lds + 89664);
    for (int idx = tid; idx < 4 * 32 * 64; idx += NTHREADS) { const int tap = idx >> 11, jj = (idx >> 6) & 31, i = idx & 63;
        const float v = (jj < 16) ? wa[((size_t)n * 64 + i) * 64 + 16 * jq + jj] : wx[((size_t)n * 64 + i) * 64 + 16 * jq + jj - 16];
        Wt[(tap * 32 + jj) * 72 + i] = cvt1(v * conv_w[tap * 512 + 64 * n + i]); }
    const int j = tid & 15, seg = tid >> 4;
    const int cch = 64 * n + 16 * jq + j;
    float bav = ba[cch], bxv = bx[cch];
    for (int i = 0; i < 64; ++i) { const float cbi = conv_b[64 * n + i]; bav += cbi * wa[((size_t)n * 64 + i) * 64 + 16 * jq + j]; bxv += cbi * wx[((size_t)n * 64 + i) * 64 + 16 * jq + j]; }
    const float c8 = -8.0f * log1pf(expf(-lam[cch]));
    const float cw0 = conv_w[cch], cw1 = conv_w[512 + cch], cw2 = conv_w[1024 + cch], cw3 = conv_w[1536 + cch], cbv = conv_b[cch];
    const int o8 = tid & 7;
    float h_in = 0.f;
    const size_t rowb = (size_t)b * SEQ;
#define RG_GLD(dst, p) asm volatile("global_load_dwordx4 %0, %1, off" : "=v"(dst) : "v"(p) : "memory")
    u32x4 rr[5];
#pragma unroll
    for (int i = 0; i < 5; ++i) { const int idx = tid + 512 * i; const int r = (idx < 259 * 8) ? (idx >> 3) : 258; const int tok = (r >= 3) ? r - 3 : 0;
        const bf16_t* p_ = z + (rowb + tok) * EVEN_IN + 2560 + 64 * n + o8 * 8; RG_GLD(rr[i], p_); }
    for (int tile = 0; tile < 16; ++tile) {
        const int t0 = tile * 256;
        if (tile == 0) { asm volatile("s_waitcnt vmcnt(0)" : "+v"(rr[0]), "+v"(rr[1]), "+v"(rr[2]), "+v"(rr[3]), "+v"(rr[4]) : : "memory"); if (tid < 24) rr[0] = (u32x4){0u, 0u, 0u, 0u}; }
        else asm volatile("s_waitcnt vmcnt(8)" : "+v"(rr[0]), "+v"(rr[1]), "+v"(rr[2]), "+v"(rr[3]), "+v"(rr[4]) : : "memory");
#pragma unroll
        for (int i = 0; i < 5; ++i) { const int idx = tid + 512 * i, r = idx >> 3; if (idx < 259 * 8) *(u32x4*)(raw + r * 72 + o8 * 8) = rr[i]; }
        if (tile + 1 < 16) {
#pragma unroll
            for (int i = 0; i < 5; ++i) { const int idx = tid + 512 * i; const int r = (idx < 259 * 8) ? (idx >> 3) : 258; const bf16_t* p_ = z + (rowb + t0 + 256 - 3 + r) * EVEN_IN + 2560 + 64 * n + o8 * 8; RG_GLD(rr[i], p_); } }
        unsigned gb[8];
#pragma unroll
        for (int i = 0; i < 8; ++i) gb[i] = z[(rowb + t0 + 8 * seg + i) * EVEN_IN + 2048 + cch];
        LBAR();
#pragma unroll
        for (int mi = 0; mi < 2; ++mi) { const int mt = 2 * w + mi;
            f32x4 acc0 = (f32x4){0.f, 0.f, 0.f, 0.f}, acc1 = (f32x4){0.f, 0.f, 0.f, 0.f};
#pragma unroll
            for (int tap = 0; tap < 4; ++tap) {
                const bf16x8 a0 = ldfrag(raw + (16 * mt + l15 + tap) * 72 + 8 * lg), a1 = ldfrag(raw + (16 * mt + l15 + tap) * 72 + 32 + 8 * lg);
                acc0 = MFMA16(a0, ldfrag(Wt + (tap * 32 + l15) * 72 + 8 * lg), acc0); acc0 = MFMA16(a1, ldfrag(Wt + (tap * 32 + l15) * 72 + 32 + 8 * lg), acc0);
                acc1 = MFMA16(a0, ldfrag(Wt + (tap * 32 + 16 + l15) * 72 + 8 * lg), acc1); acc1 = MFMA16(a1, ldfrag(Wt + (tap * 32 + 16 + l15) * 72 + 32 + 8 * lg), acc1); }
#pragma unroll
            for (int reg = 0; reg < 4; ++reg) { G[(16 * mt + 4 * lg + reg) * 33 + l15] = acc0[reg]; G[(16 * mt + 4 * lg + reg) * 33 + 16 + l15] = acc1[reg]; } }
        LBAR();
        float av[8], uv[8]; float Ac = 1.f, Hc = 0.f;
#pragma unroll
        for (int i = 0; i < 8; ++i) { const int t = 8 * seg + i;
            const float gr = G[t * 33 + j] + bav, gi = G[t * 33 + 16 + j] + bxv;
            const float r = __builtin_amdgcn_rcpf(1.0f + __expf(-gr)), ig = __builtin_amdgcn_rcpf(1.0f + __expf(-gi));
            const float la = c8 * r; const float aa = __expf(la); const float t2 = 2.0f * la;
            const float om = (t2 > -0.02f) ? -(t2 + 0.5f * t2 * t2 + 0.16666667f * t2 * t2 * t2) : (1.0f - aa * aa);
            const float m2 = __builtin_amdgcn_sqrtf(fmaxf(om, 0.f));
            const int cl = 16 * jq + j;
            const float xf = cbv + cw0 * bf2f(raw[(t + 0) * 72 + cl]) + cw1 * bf2f(raw[(t + 1) * 72 + cl]) + cw2 * bf2f(raw[(t + 2) * 72 + cl]) + cw3 * bf2f(raw[(t + 3) * 72 + cl]);
            const float u = m2 * (ig * xf);
            av[i] = aa; uv[i] = u; Ac *= aa; Hc = aa * Hc + u; }
        AH[(seg * 16 + j) * 2] = Ac; AH[(seg * 16 + j) * 2 + 1] = Hc;
        LBAR();
        float cur = h_in, hs = 0.f;
#pragma unroll
        for (int s = 0; s < 32; ++s) { const f32x2_t ah = *(const f32x2_t*)(AH + (s * 16 + j) * 2); if (s == seg) hs = cur; cur = ah.x * cur + ah.y; }
        float hh = hs;
#pragma unroll
        for (int i = 0; i < 8; ++i) { hh = av[i] * hh + uv[i]; const float g = bf2f(gb[i]);
            const float u = 0.7978845608028654f * (g + 0.044715f * g * g * g); const float th = 1.0f - 2.0f * __builtin_amdgcn_rcpf(1.0f + __expf(2.0f * u));
            const float ge = 0.5f * g * (1.0f + th);
            y[(rowb + t0 + 8 * seg + i) * DM + 512 + cch] = cvt1(hh * ge); }
        h_in = cur;
    }
    __syncthreads();
}

__device__ __forceinline__ void qk_rot(const u32x4 r1, const u32x4 r2, const f32x4 g1a, const f32x4 g1b, const f32x4 g2a, const f32x4 g2b, const f32x4 ca, const f32x4 cb, const f32x4 sa, const f32x4 sb, int p, float scale, bf16_t* dst) {
    float x1[8], x2[8];
    x1[0] = bflo(r1.x); x1[1] = bfhi(r1.x); x1[2] = bflo(r1.y); x1[3] = bfhi(r1.y); x1[4] = bflo(r1.z); x1[5] = bfhi(r1.z); x1[6] = bflo(r1.w); x1[7] = bfhi(r1.w);
    x2[0] = bflo(r2.x); x2[1] = bfhi(r2.x); x2[2] = bflo(r2.y); x2[3] = bfhi(r2.y); x2[4] = bflo(r2.z); x2[5] = bfhi(r2.z); x2[6] = bflo(r2.w); x2[7] = bfhi(r2.w);
    float ss = 0.f;
#pragma unroll
    for (int i = 0; i < 8; ++i) ss += x1[i] * x1[i] + x2[i] * x2[i];
    ss += __shfl_xor(ss, 1); ss += __shfl_xor(ss, 2);
    const float rs = rsqrtf(ss * (1.0f / 64.0f) + 1e-6f) * scale;
    float o1[8], o2[8];
#pragma unroll
    for (int i = 0; i < 8; ++i) { const float c = (i < 4) ? ca[i & 3] : cb[i & 3], sn = (i < 4) ? sa[i & 3] : sb[i & 3];
        const float g1 = (i < 4) ? g1a[i & 3] : g1b[i & 3], g2 = (i < 4) ? g2a[i & 3] : g2b[i & 3];
        const float y1 = x1[i] * rs * g1, y2 = x2[i] * rs * g2;
        o1[i] = y1 * c - y2 * sn; o2[i] = y2 * c + y1 * sn; }
    u32x4 w1, w2; w1.x = cvtpk(o1[0], o1[1]); w1.y = cvtpk(o1[2], o1[3]); w1.z = cvtpk(o1[4], o1[5]); w1.w = cvtpk(o1[6], o1[7]);
    w2.x = cvtpk(o2[0], o2[1]); w2.y = cvtpk(o2[2], o2[3]); w2.z = cvtpk(o2[4], o2[5]); w2.w = cvtpk(o2[6], o2[7]);
    *(u32x4*)(dst + 8 * p) = w1; *(u32x4*)(dst + 32 + 8 * p) = w2;
}

__device__ __forceinline__ void swa_item(unsigned char* lds, int b, int n, int kvh, const bf16_t* z, bf16_t* y, const float* cosT, const float* sinT,
                                         const float* qn, const float* kn, const float* sinks) {
    int tid_ = threadIdx.x; asm volatile("" : "+v"(tid_));
    const int tid = tid_, lane = tid & 63, w = tid >> 6, l15 = lane & 15, lg = lane >> 4;
    bf16_t* Ks = (bf16_t*)lds;
    bf16_t* VT = (bf16_t*)(lds + 36864);
    bf16_t* Qs4 = (bf16_t*)(lds + 72704);
    const size_t tok0 = (size_t)b * SEQ + 128 * n;
    const int prow = tid >> 2, pp = tid & 3;
    const bool first = (n == 0);
    const u32x4 zz = (u32x4){0u, 0u, 0u, 0u}; const f32x4 zf = (f32x4){0.f, 0.f, 0.f, 0.f};
    u32x4 k0a = zz, k0b = zz; f32x4 c0a = zf, c0b = zf, s0a = zf, s0b = zf;
    if (!first) { const size_t tok = tok0 - 128 + prow; const bf16_t* kp = z + tok * ODD_IN + 1024 + kvh * 64;
        k0a = *(const u32x4*)(kp + 8 * pp); k0b = *(const u32x4*)(kp + 32 + 8 * pp);
        c0a = *(const f32x4*)(cosT + tok * 32 + 8 * pp); c0b = *(const f32x4*)(cosT + tok * 32 + 8 * pp + 4); s0a = *(const f32x4*)(sinT + tok * 32 + 8 * pp); s0b = *(const f32x4*)(sinT + tok * 32 + 8 * pp + 4); }
    const size_t tokq = tok0 + prow;
    const bf16_t* kp1 = z + tokq * ODD_IN + 1024 + kvh * 64;
    const u32x4 k1a = *(const u32x4*)(kp1 + 8 * pp), k1b = *(const u32x4*)(kp1 + 32 + 8 * pp);
    const f32x4 c1a = *(const f32x4*)(cosT + tokq * 32 + 8 * pp), c1b = *(const f32x4*)(cosT + tokq * 32 + 8 * pp + 4), s1a = *(const f32x4*)(sinT + tokq * 32 + 8 * pp), s1b = *(const f32x4*)(sinT + tokq * 32 + 8 * pp + 4);
    u32x4 vv[4];
#pragma unroll
    for (int i = 0; i < 4; ++i) { const int idx = tid + 512 * i, r = idx & 255, c8 = idx >> 8; vv[i] = zz;
        if (!(first && r < 128)) vv[i] = *(const u32x4*)(z + (tok0 - 128 + r) * ODD_IN + 1280 + kvh * 64 + c8 * 8); }
    const f32x4 kg1a = *(const f32x4*)(kn + 8 * pp), kg1b = *(const f32x4*)(kn + 8 * pp + 4), kg2a = *(const f32x4*)(kn + 32 + 8 * pp), kg2b = *(const f32x4*)(kn + 32 + 8 * pp + 4);
    f32x4 qg1a = *(const f32x4*)(qn + 8 * pp), qg1b = *(const f32x4*)(qn + 8 * pp + 4), qg2a = *(const f32x4*)(qn + 32 + 8 * pp), qg2b = *(const f32x4*)(qn + 32 + 8 * pp + 4);
    float sinkv[4];
#pragma unroll
    for (int g = 0; g < 4; ++g) sinkv[g] = sinks[kvh * 4 + g];
    u32x4 qa_[4], qb_[4];
#pragma unroll
    for (int g = 0; g < 4; ++g) { const bf16_t* qp = z + tokq * ODD_IN + (kvh * 4 + g) * 64; qa_[g] = *(const u32x4*)(qp + 8 * pp); qb_[g] = *(const u32x4*)(qp + 32 + 8 * pp); }
    if (first) { *(u32x4*)(Ks + prow * 72 + 8 * pp) = zz; *(u32x4*)(Ks + prow * 72 + 32 + 8 * pp) = zz; }
    else qk_rot(k0a, k0b, kg1a, kg1b, kg2a, kg2b, c0a, c0b, s0a, s0b, pp, 1.0f, Ks + prow * 72);
    qk_rot(k1a, k1b, kg1a, kg1b, kg2a, kg2b, c1a, c1b, s1a, s1b, pp, 1.0f, Ks + (128 + prow) * 72);
#pragma unroll
    for (int i = 0; i < 4; ++i) { const int idx = tid + 512 * i, r = idx & 255, c8 = idx >> 8; const u32x4 v = vv[i];
        VT[(c8 * 8 + 0) * 280 + r] = (bf16_t)(v.x & 0xffffu); VT[(c8 * 8 + 1) * 280 + r] = (bf16_t)(v.x >> 16);
        VT[(c8 * 8 + 2) * 280 + r] = (bf16_t)(v.y & 0xffffu); VT[(c8 * 8 + 3) * 280 + r] = (bf16_t)(v.y >> 16);
        VT[(c8 * 8 + 4) * 280 + r] = (bf16_t)(v.z & 0xffffu); VT[(c8 * 8 + 5) * 280 + r] = (bf16_t)(v.z >> 16);
        VT[(c8 * 8 + 6) * 280 + r] = (bf16_t)(v.w & 0xffffu); VT[(c8 * 8 + 7) * 280 + r] = (bf16_t)(v.w >> 16); }
    for (int idx = tid; idx < 64 * 24; idx += NTHREADS) VT[(idx / 24) * 280 + 256 + (idx % 24)] = 0;
    asm volatile("s_waitcnt vmcnt(0)" : "+v"(qa_[0]), "+v"(qa_[1]), "+v"(qa_[2]), "+v"(qa_[3]), "+v"(qb_[0]), "+v"(qb_[1]), "+v"(qb_[2]), "+v"(qb_[3]), "+v"(qg1a), "+v"(qg1b), "+v"(qg2a), "+v"(qg2b) : : "memory");
    asm volatile("" : "+v"(sinkv[0]), "+v"(sinkv[1]), "+v"(sinkv[2]), "+v"(sinkv[3]));
#pragma unroll
    for (int g = 0; g < 4; ++g) qk_rot(qa_[g], qb_[g], qg1a, qg1b, qg2a, qg2b, c1a, c1b, s1a, s1b, pp, 0.125f, Qs4 + g * (128 * 72) + prow * 72);
    LBAR();
#pragma unroll
    for (int g = 0; g < 4; ++g) {
        const int hq = kvh * 4 + g;
        bf16_t* Qs = Qs4 + g * (128 * 72); bf16_t* Pw = Qs + (16 * w) * 72;
        const float sink = sinkv[g];
        const bf16x8 qf0 = ldfrag(Qs + (16 * w + l15) * 72 + 8 * lg), qf1 = ldfrag(Qs + (16 * w + l15) * 72 + 32 + 8 * lg);
        f32x4 sc[9];
#pragma unroll
        for (int kt = 0; kt < 9; ++kt) { const int kr = 16 * (w + kt) + l15; f32x4 acc = (f32x4){0.f, 0.f, 0.f, 0.f};
            acc = MFMA16(ldfrag(Ks + kr * 72 + 8 * lg), qf0, acc); acc = MFMA16(ldfrag(Ks + kr * 72 + 32 + 8 * lg), qf1, acc); sc[kt] = acc; }
        float m = -1e30f;
#pragma unroll
        for (int kt = 0; kt < 9; ++kt) {
            const bool tile_ok = !first || (w + kt >= 8);
#pragma unroll
            for (int reg = 0; reg < 4; ++reg) { const int dlt = l15 - 4 * lg - reg;
                bool valid = tile_ok; if (kt == 0) valid = valid && (dlt < 0); if (kt == 8) valid = valid && (dlt >= 0);
                const float v = valid ? sc[kt][reg] : -1e30f; sc[kt][reg] = v; m = fmaxf(m, v); } }
        m = fmaxf(m, __shfl_xor(m, 16)); m = fmaxf(m, __shfl_xor(m, 32)); m = fmaxf(m, sink);
        float sm = 0.f;
#pragma unroll
        for (int kt = 0; kt < 9; ++kt)
#pragma unroll
            for (int reg = 0; reg < 4; ++reg) { const float p = __expf(sc[kt][reg] - m); sc[kt][reg] = p; sm += p; }
        sm += __shfl_xor(sm, 16); sm += __shfl_xor(sm, 32);
        const float invq = __builtin_amdgcn_rcpf(sm + __expf(sink - m));
        float inv[4];
#pragma unroll
        for (int reg = 0; reg < 4; ++reg) inv[reg] = __shfl(invq, 4 * lg + reg);
        bf16x8 pa[5];
#pragma unroll
        for (int ks = 0; ks < 5; ++ks) { u32x4 pw; pw.x = cvtpk(sc[2 * ks][0], sc[2 * ks][1]); pw.y = cvtpk(sc[2 * ks][2], sc[2 * ks][3]);
            if (ks < 4) { pw.z = cvtpk(sc[2 * ks + 1][0], sc[2 * ks + 1][1]); pw.w = cvtpk(sc[2 * ks + 1][2], sc[2 * ks + 1][3]); } else { pw.z = 0u; pw.w = 0u; }
            pa[ks] = __builtin_bit_cast(bf16x8, pw); }
#pragma unroll
        for (int dt = 0; dt < 4; ++dt) { f32x4 acc = (f32x4){0.f, 0.f, 0.f, 0.f};
#pragma unroll
            for (int ks = 0; ks < 5; ++ks) { const bf16_t* vp = VT + (16 * dt + l15) * 280 + 16 * w + 32 * ks + 4 * lg;
                u32x4 bw; const u32x2 lo = *(const u32x2*)vp, hi = *(const u32x2*)(vp + 16); bw.x = lo.x; bw.y = lo.y; bw.z = hi.x; bw.w = hi.y;
                acc = MFMA16(pa[ks], __builtin_bit_cast(bf16x8, bw), acc); }
#pragma unroll
            for (int reg = 0; reg < 4; ++reg) Pw[(4 * lg + reg) * 72 + 16 * dt + l15] = cvt1(acc[reg] * inv[reg]); }
        asm volatile("s_waitcnt lgkmcnt(0)" ::: "memory");
#pragma unroll
        for (int i = 0; i < 2; ++i) { const int idx = lane + 64 * i, row = idx >> 3, ch = idx & 7;
            *(u32x4*)(y + (tok0 + 16 * w + row) * DM + hq * 64 + ch * 8) = *(const u32x4*)(Pw + row * 72 + ch * 8); }
        asm volatile("" ::: "memory");
    }
    LBAR();
}

#define XB_TMO      128
#define XB_XCNT(j)  (256  + 64 * (j))
#define XB_XSUB(j)  (1280 + 64 * (j))
#define XB_XGEN(j)  (2304 + 64 * (j))
#define XB_TOP      3328
#define XB_TOPGEN   3392
#define XCD_BAR_WORDS 3456
#define XB_SPIN_CAP (1u << 18)

__device__ __forceinline__ unsigned xb_ld(unsigned* p)              { return __hip_atomic_load(p, __ATOMIC_RELAXED, __HIP_MEMORY_SCOPE_AGENT); }
__device__ __forceinline__ unsigned xb_add(unsigned* p, unsigned v) { return __hip_atomic_fetch_add(p, v, __ATOMIC_RELAXED, __HIP_MEMORY_SCOPE_AGENT); }
__device__ __forceinline__ unsigned xb_xcc_id() { return (unsigned)__builtin_amdgcn_s_getreg((3 << 11) | 20) & 0xFu; }
#define XB_SPIN(cond, bar) do { unsigned _sp = 0; while (cond) { __builtin_amdgcn_s_sleep(1); \
    if ((++_sp & 255u) == 0u) { if (xb_ld(&(bar)[XB_TMO])) break; if (_sp > XB_SPIN_CAP) { atomicAdd(&(bar)[XB_TMO], 1u); break; } } } } while (0)

struct XcdBarrier {
    unsigned* bar; unsigned x;
    volatile LAS unsigned* st;
};

__device__ __forceinline__ XcdBarrier xcd_barrier_post(unsigned* bar, volatile LAS unsigned* st) {
    XcdBarrier b; b.bar = bar; b.x = xb_xcc_id(); b.st = st;
    if (threadIdx.x == 0) (void)xb_add(&bar[XB_XCNT(b.x)], 1u);
    return b;
}
__device__ __forceinline__ void xcd_barrier_complete(unsigned* bar, unsigned x, unsigned& nloc, unsigned& nx) {
    const unsigned G = gridDim.x * gridDim.y * gridDim.z;
    unsigned sum, cnt, mine, sp = 0u;
    for (;;) {
        sum = 0u; cnt = 0u; mine = 0u;
#pragma unroll
        for (unsigned j = 0; j < 16; ++j) { const unsigned c = xb_ld(&bar[XB_XCNT(j)]); sum += c; cnt += (c > 0u) ? 1u : 0u; mine = (j == x) ? c : mine; }
        if (sum == G) break;
        __builtin_amdgcn_s_sleep(1);
        if ((++sp & 255u) == 0u) { if (xb_ld(&bar[XB_TMO])) break; if (sp > XB_SPIN_CAP) { atomicAdd(&bar[XB_TMO], 1u); break; } }
    }
    nloc = mine > 0u ? mine : 1u; nx = cnt > 0u ? cnt : 1u;
}

__device__ __forceinline__ void xcd_barrier(const XcdBarrier& b) {
    asm volatile("s_waitcnt vmcnt(0)" ::: "memory");
    __syncthreads();
    if (threadIdx.x == 0) {
        unsigned* bar = b.bar;
        __builtin_amdgcn_s_waitcnt(0);
        unsigned nloc = b.st[0], nx = b.st[1];
        if (nloc == 0u) { xcd_barrier_complete(bar, b.x, nloc, nx); b.st[0] = nloc; b.st[1] = nx; }
        const unsigned old = xb_add(&bar[XB_XSUB(b.x)], 1u);
        const unsigned gen = old / nloc;
        if (old + 1u == (gen + 1u) * nloc) {
            __builtin_amdgcn_fence(__ATOMIC_RELEASE, "agent");
            asm volatile("s_waitcnt vmcnt(0)" ::: "memory");
            const unsigned og = xb_add(&bar[XB_TOP], 1u);
            const unsigned tg = og / nx;
            if (og + 1u == (tg + 1u) * nx) xb_add(&bar[XB_TOPGEN], 1u);
            else XB_SPIN(xb_ld(&bar[XB_TOPGEN]) == tg, bar);
            __builtin_amdgcn_fence(__ATOMIC_ACQUIRE, "agent");
            xb_add(&bar[XB_XGEN(b.x)], 1u);
            asm volatile("s_waitcnt vmcnt(0)" ::: "memory");
        } else {
            XB_SPIN(xb_ld(&bar[XB_XGEN(b.x)]) == gen, bar);
            __builtin_amdgcn_fence(__ATOMIC_ACQUIRE, "agent");
            asm volatile("s_waitcnt vmcnt(0)" ::: "memory");
        }
    }
    __syncthreads();
}

__device__ __forceinline__ void xcd_local_barrier(const XcdBarrier& b, unsigned* lbar) {
    asm volatile("s_waitcnt vmcnt(0)" ::: "memory");
    __syncthreads();
    if (threadIdx.x == 0) {
        __builtin_amdgcn_s_waitcnt(0);
        const unsigned nloc = b.st[0];
        const unsigned old = xb_add(&lbar[XB_XSUB(b.x)], 1u);
        const unsigned gen = old / nloc;
        if (old + 1u == (gen + 1u) * nloc) xb_add(&lbar[XB_XGEN(b.x)], 1u);
        else XB_SPIN(xb_ld(&lbar[XB_XGEN(b.x)]) == gen, lbar);
        __builtin_amdgcn_fence(__ATOMIC_ACQUIRE, "agent");
        asm volatile("s_waitcnt vmcnt(0)" ::: "memory");
    }
    __syncthreads();
}

#ifndef MK_MULTI
#define MK_MULTI 0
#endif
#define PROBE_DUP 0
__global__ void __launch_bounds__(NTHREADS, 2) trunk_fwd(Args a) {
    extern __shared__ __attribute__((aligned(16))) unsigned char lds[];
    cg::grid_group grid = cg::this_grid();
    const int G = gridDim.x, bid = blockIdx.x;
    unsigned char* ws = a.ws;
    float* rowsq = (float*)(ws + WS_ROWSQ);
    bf16_t* XB = (bf16_t*)(ws + WS_XB); bf16_t* XLO = (bf16_t*)(ws + WS_LO); bf16_t* HID = (bf16_t*)(ws + WS_HID);
    const bool grp = (G == 256); const size_t gb = (size_t)(bid & 7);
    bf16_t* Zev = grp ? (bf16_t*)(ws + WS_Z + gb * (8 * MiB)) : (bf16_t*)(ws + WS_Z);
    bf16_t* Zod = grp ? (bf16_t*)(ws + WS_Z + gb * (20 * MiB)) : (bf16_t*)(ws + WS_Z);
    bf16_t* Y = grp ? (bf16_t*)(ws + WS_Z + 24 * MiB + gb * (24 * MiB)) : (bf16_t*)(ws + WS_Y);
    const float* cosT = (const float*)(ws + WS_COS); const float* sinT = (const float*)(ws + WS_SIN);
    const int lo = a.ph_lo, hi = a.ph_hi;
#define IN(k) (lo <= (k) && (k) < hi)
    { volatile LAS unsigned* st = (volatile LAS unsigned*)((LAS unsigned char*)lds + (LDS_BYTES - 64)); if (threadIdx.x < 2) st[threadIdx.x] = 0u; }
    __syncthreads();
    XcdBarrier bar = xcd_barrier_post((unsigned*)(ws + WS_BAR), (volatile LAS unsigned*)((LAS unsigned char*)lds + (LDS_BYTES - 64)));
    unsigned* lbar = (unsigned*)(ws + WS_BAR) + XCD_BAR_WORDS;
    if (threadIdx.x == 0) { if (!grp) (void)xb_add(&lbar[0], 1u); __hip_atomic_fetch_or(&lbar[16 + (bid & 7)], 1u << bar.x, __ATOMIC_RELAXED, __HIP_MEMORY_SCOPE_AGENT); }
    bool use_local = false;
    const int last_seam = N_PHASES - 2;
#define SEAM(k) do { if (IN(k) && IN((k) + 1)) { if (use_local && (k) != 0 && (k) != last_seam) xcd_local_barrier(bar, lbar); else xcd_barrier(bar); \
        if ((k) == 0) { unsigned all_ = 0u; bool one_ = true; for (int g_ = 0; g_ < 8; ++g_) { const unsigned m_ = xb_ld(&lbar[16 + g_]); one_ = one_ && (__builtin_popcount(m_) == 1); all_ |= m_; } \
            use_local = (xb_ld(&lbar[0]) == 0u) && one_ && (__builtin_popcount(all_) == 8); } } } while (0)
    if (a.ph_hi < 0) grid.sync();
#ifndef NO_P0
    if (IN(0)) { for (int rep = 0; rep < (PROBE_DUP == 4 ? 2 : 1); ++rep) { p0_prologue(a, lds); __syncthreads(); } }
#endif
    SEAM(0);
    for (int l = 0; l < DEPTH; ++l) {
        const int pb = 1 + 7 * l; const bool even = (l & 1) == 0; const int li = l >> 1;
        bf16_t* Zl = even ? Zev : Zod;
        if (IN(pb)) for (int rep = 0; rep < (PROBE_DUP == 5 ? 2 : 1); ++rep) {
            const int N = even ? EVEN_IN : ODD_IN;
            const bf16_t* Wt = even ? (const bf16_t*)(ws + WS_WIN_EVEN) + (size_t)li * DM * EVEN_IN : (const bf16_t*)(ws + WS_WIN_ODD) + (size_t)li * DM * ODD_IN;
            pg8::Gemm g{XB, Wt, M_TOK, N, DM}; pg8::StaticOrder S; S.init(M_TOK, N, G, bid);
            pg8::EpiScaleBf16<0> E{Zl, N, rowsq + (size_t)(2 * l) * M_TOK * 16};
#if !defined(NO_GEMM) && !defined(NO_G1)
            pg8::gemm_phase<pg8::EpiScaleBf16<0>, pg8::StaticOrder, true, true>((LAS unsigned char*)lds, g, S, E);
#endif
        }
        SEAM(pb);
        if (IN(pb + 1)) {
            if (even) {
                if (G == 256) hgrn_s1(lds, (bid & 7) * 256 + (bid >> 3), 32, (bid & 7) * 256 + 256, Zl, ws, (unsigned char*)a.out, a.in[8], li);
                else hgrn_s1(lds, bid, G, 2048, Zl, ws, (unsigned char*)a.out, a.in[8], li);
                for (int it = (G == 256 ? ((bid & 7) * 32 + (bid >> 3)) : bid); it < 256; it += G)
                    rglru_item(lds, it >> 5, (it >> 2) & 7, it & 3, Zl, Y, a.in[10] + li * 2048, a.in[11] + li * 512, a.in[12] + (size_t)li * 32768, a.in[13] + li * 512,
                               a.in[14] + (size_t)li * 32768, a.in[15] + li * 512, a.in[16] + li * 512);
            } else {
                for (int it = (G == 256 ? ((bid & 7) * 128 + (bid >> 3)) : bid); it < (G == 256 ? (bid & 7) * 128 + 128 : 1024); it += (G == 256 ? 32 : G))
                    swa_item(lds, it >> 7, (it >> 2) & 31, it & 3, Zl, Y, cosT, sinT, a.in[19] + li * 64, a.in[20] + li * 64, a.in[21] + li * 16);
            }
        }
        if (even) SEAM(pb + 1);
        if (IN(pb + 2) && even) { for (int blk = (G == 256 ? ((bid & 7) * 16 + (bid >> 3)) : bid); blk < 128 && (G != 256 || bid < 128); blk += G) hgrn_s2(lds, blk, ws, (const unsigned char*)a.out, Y); }
        if (even) SEAM(pb + 2);
        if (IN(pb + 3) && even) hgrn_s3(G, bid, Zl, Y, a.in[9] + li * 512);
        SEAM(pb + 3);
        if (IN(pb + 4)) {
            const bf16_t* Wt = even ? (const bf16_t*)(ws + WS_WOUT_EVEN) + (size_t)li * DM * DM : (const bf16_t*)(ws + WS_WOUT_ODD) + (size_t)li * DM * DM;
            pg8::Gemm g{Y, Wt, M_TOK, DM, DM}; pg8::StaticOrder S; S.init(M_TOK, DM, G, bid);
            pg8::EpiResid E{XB, XLO, nullptr, rowsq + (size_t)(2 * l + 1) * M_TOK * 16, DM};
#if !defined(NO_GEMM) && !defined(NO_G2)
            pg8::gemm_phase<pg8::EpiResid, pg8::StaticOrder, true, true>((LAS unsigned char*)lds, g, S, E);
#endif
        }
        SEAM(pb + 4);
        if (IN(pb + 5)) for (int rep = 0; rep < (PROBE_DUP == 3 ? 2 : 1); ++rep) {
            pg8::Gemm g{XB, (const bf16_t*)(ws + WS_WMLP_IN) + (size_t)l * DM * DFF, M_TOK, DFF, DM}; pg8::StaticOrder S; S.init(M_TOK, DFF, G, bid);
            pg8::EpiScaleBf16<1> E{HID, DFF, rowsq + (size_t)(2 * l + 1) * M_TOK * 16};
#if !defined(NO_GEMM) && !defined(NO_G3)
            pg8::gemm_phase<pg8::EpiScaleBf16<1>, pg8::StaticOrder, true, true>((LAS unsigned char*)lds, g, S, E);
#endif
        }
        SEAM(pb + 5);
        if (IN(pb + 6)) {
            pg8::Gemm g{HID, (const bf16_t*)(ws + WS_WMLP_OUT) + (size_t)l * DM * DFF, M_TOK, DM, DFF}; pg8::StaticOrder S; S.init(M_TOK, DM, G, bid);
            pg8::EpiResid E{XB, XLO, (l + 1 < DEPTH) ? nullptr : a.out, (l + 1 < DEPTH) ? rowsq + (size_t)(2 * l + 2) * M_TOK * 16 : nullptr, DM};
#if !defined(NO_GEMM) && !defined(NO_G4)
            pg8::gemm_phase<pg8::EpiResid, pg8::StaticOrder, true, true>((LAS unsigned char*)lds, g, S, E);
#endif
        }
        SEAM(pb + 6);
    }
#undef IN
#undef SEAM
}

extern "C" void kernel_launch(void* const* d_in, const int* in_sizes, int n_in, void* d_out, int out_size, void* d_ws, size_t ws_size, hipStream_t stream) {
    static int grid = 0;
    if (grid == 0) {
        if (n_in != 22 || out_size != M_TOK * DM || ws_size < WS_END) { fprintf(stderr, "kernel_launch: unexpected shapes (n_in %d out %d ws %zu)\n", n_in, out_size, ws_size); grid = -1; return; }
        int dev = 0, cus = 0, per_cu = 0;
        (void)hipGetDevice(&dev); (void)hipDeviceGetAttribute(&cus, hipDeviceAttributeMultiprocessorCount, dev);
        if (hipFuncSetAttribute((const void*)trunk_fwd, hipFuncAttributeMaxDynamicSharedMemorySize, LDS_BYTES) != hipSuccess) { fprintf(stderr, "kernel_launch: hipFuncSetAttribute failed\n"); grid = -1; return; }
        if (hipOccupancyMaxActiveBlocksPerMultiprocessor(&per_cu, (const void*)trunk_fwd, NTHREADS, LDS_BYTES) != hipSuccess || per_cu < 1) { fprintf(stderr, "kernel_launch: occupancy query says %d\n", per_cu); per_cu = 1; }
        (void)hipGetLastError();
        grid = cus;
    }
    if (grid < 0) return;
    (void)hipMemsetAsync((char*)d_ws + WS_BAR, 0, 2 * XCD_BAR_WORDS * 4, stream);
    Args a{};
    for (int i = 0; i < 22; ++i) a.in[i] = (const float*)d_in[i];
    a.pos = (const int*)d_in[1]; a.out = (float*)d_out; a.ws = (unsigned char*)d_ws;
#if MK_MULTI
    for (int ph = 0; ph < N_PHASES; ++ph) { a.ph_lo = ph; a.ph_hi = ph + 1; hipLaunchKernelGGL(trunk_fwd, dim3(grid), dim3(NTHREADS), LDS_BYTES, stream, a); }
#else
    a.ph_lo = 0; a.ph_hi = N_PHASES;
    void* args[] = {&a};
    hipError_t e = hipLaunchCooperativeKernel((const void*)trunk_fwd, dim3(grid), dim3(NTHREADS), args, LDS_BYTES, stream);
    if (e != hipSuccess) fprintf(stderr, "cooperative launch failed: %s (grid %d)\n", hipGetErrorString(e), grid);
#endif
}
```

```cpp
#include <hip/hip_runtime.h>
#include <hip/hip_cooperative_groups.h>
#include <cstdio>
#include <cstdint>
namespace cg = cooperative_groups;
namespace pg8 {
#define PG8_LAS __attribute__((address_space(3)))
typedef unsigned short bf16_t;
typedef short bf16x8 __attribute__((ext_vector_type(8)));
typedef float f32x4 __attribute__((ext_vector_type(4)));
typedef unsigned u32x4 __attribute__((ext_vector_type(4)));
constexpr int BM = 256, BK = 64, HALF = 128, HTB = HALF * BK * 2  , STAGE_BYTES = 8 * HTB, NXCD = 8, WGM = 8;

__host__ __device__ __forceinline__ int lds_byte(int r, int c) { const int st = (r >> 4) * 2 + (c >> 5), rr = r & 15, cc = c & 31, ob = rr * 64 + cc * 2; return st * 1024 + (ob ^ (((ob >> 9) & 1) << 5)); }
__host__ __device__ __forceinline__ void stage_rc(int b, int& R, int& C) { const int st = b / 1024, sb = b % 1024, swz = sb ^ (((sb >> 9) & 1) << 5); R = (st >> 1) * 16 + swz / 64; C = (st & 1) * 32 + (swz % 64) / 2; }
__host__ __device__ __forceinline__ int perm32(int rho) { const int n = rho >> 4, i = rho & 15; return 8 * (i >> 2) + 4 * n + (i & 3); }

struct Unit { int pm, pn; };
struct Gemm { const bf16_t* A; const bf16_t* Bt; int M, N, K; };

struct StaticOrder {
    int nM, nN, nwg, G, c;
    __host__ __device__ void init(int M, int N, int G_, int c_) { nM = M / BM; nN = N / BM; nwg = nM * nN; G = G_; c = c_; }
    __host__ __device__ bool next(int i, Unit& u) const {
        const long L = (long)i * G + c; if (L >= nwg) return false;
        int wgid = (int)L; { const int q = nwg / NXCD, r = nwg % NXCD, xcd = wgid % NXCD, off = wgid / NXCD; wgid = (xcd < r ? xcd * (q + 1) : r * (q + 1) + (xcd - r) * q) + off; }
        const int nig = WGM * nN, gid = wgid / nig, fm = gid * WGM, gsz = (nM - fm) < WGM ? (nM - fm) : WGM;
        u.pm = fm + ((wgid % nig) % gsz); u.pn = (wgid % nig) / gsz; return true;
    }
    __device__ __forceinline__ void a_ready(const Unit&) const {}
    __device__ __forceinline__ void done(const Unit&) const {}
};
__device__ __forceinline__ unsigned cvt_pk_bf16(float lo, float hi) { unsigned r; asm volatile("v_cvt_pk_bf16_f32 %0, %1, %2" : "=v"(r) : "v"(lo), "v"(hi)); return r; }
template <int ACT> struct EpiScaleBf16 {
    static constexpr bool PERM = true, AFTER_DRAIN = false;
    bf16_t* O; int ldc; const float* rowsq;
    __device__ __forceinline__ void operator()(const f32x4 (&acc)[2][2][4][2], const Unit& u, int wr, int wc, int fr, int fq) const {
        const int row0 = u.pm * BM + wr * 64 + fr; const int col0 = u.pn * BM + wc * 32 + 8 * fq;
        f32x4 pr[2][4];
#pragma unroll
        for (int ai = 0; ai < 2; ++ai)
#pragma unroll
            for (int m = 0; m < 4; ++m) pr[ai][m] = *(const f32x4*)(rowsq + (size_t)(row0 + ai * HALF + m * 16) * 16 + 4 * fq);
        float rsv[2][4];
#pragma unroll
        for (int ai = 0; ai < 2; ++ai)
#pragma unroll
            for (int m = 0; m < 4; ++m) { float t = (pr[ai][m][0] + pr[ai][m][1]) + (pr[ai][m][2] + pr[ai][m][3]); t += __shfl_xor(t, 16); t += __shfl_xor(t, 32); rsv[ai][m] = rsqrtf(t * (1.0f / 1024.0f) + 1e-6f); }
#pragma unroll
        for (int ai = 0; ai < 2; ++ai)
#pragma unroll
            for (int m = 0; m < 4; ++m) { const int row = row0 + ai * HALF + m * 16; const float s = rsv[ai][m];
                bf16_t* rowp = O + (size_t)row * ldc + col0;
#pragma unroll
                for (int bj = 0; bj < 2; ++bj) { f32x4 v0 = acc[ai][bj][m][0] * s, v1 = acc[ai][bj][m][1] * s;
                    if (ACT == 1) {
#pragma unroll
                        for (int q = 0; q < 4; ++q) { const float a = fmaxf(v0[q], 0.f), b = fmaxf(v1[q], 0.f); v0[q] = a * a; v1[q] = b * b; } }
                    u32x4 w; w.x = cvt_pk_bf16(v0[0], v0[1]); w.y = cvt_pk_bf16(v0[2], v0[3]); w.z = cvt_pk_bf16(v1[0], v1[1]); w.w = cvt_pk_bf16(v1[2], v1[3]);
                    if (ACT == 1) __builtin_nontemporal_store(w, (u32x4*)(rowp + bj * HALF)); else *(u32x4*)(rowp + bj * HALF) = w; } }
    }
};
struct EpiResid {
    static constexpr bool PERM = true, AFTER_DRAIN = false;
    bf16_t* hi; bf16_t* lo; float* fin; float* rowsq_next; int ldc;
    __device__ __forceinline__ void operator()(const f32x4 (&acc)[2][2][4][2], const Unit& u, int wr, int wc, int fr, int fq) const {
        const int row0 = u.pm * BM + wr * 64 + fr; const int col0 = u.pn * BM + wc * 32 + 8 * fq;
        u32x4 ph[8][2], pl[8][2];
#define ER_GLD(dst, p, OFF) asm volatile("global_load_dwordx4 %0, %1, off offset:" #OFF : "=v"(dst) : "v"(p) : "memory")
#define ER_LOAD(g) do { const size_t off_ = (size_t)(row0 + ((g) >> 2) * HALF + ((g) & 3) * 16) * ldc + col0; const bf16_t* hp_ = hi + off_; const bf16_t* lp_ = lo + off_; \
            ER_GLD(ph[g][0], hp_, 0); ER_GLD(pl[g][0], lp_, 0); ER_GLD(ph[g][1], hp_, 256); ER_GLD(pl[g][1], lp_, 256); } while (0)
#define ER_WAIT(N, g) asm volatile("s_waitcnt vmcnt(" #N ")" : "+v"(ph[g][0]), "+v"(pl[g][0]), "+v"(ph[g][1]), "+v"(pl[g][1]) : : "memory")
#define ER_PROC(g) do { const int ai_ = (g) >> 2, m_ = (g) & 3; const int row_ = row0 + ai_ * HALF + m_ * 16; const size_t off_ = (size_t)row_ * ldc + col0; float ss_ = 0.f; \
            _Pragma("unroll") for (int bj = 0; bj < 2; ++bj) { unsigned ob_[8]; \
                _Pragma("unroll") for (int q = 0; q < 4; ++q) { const unsigned H = ph[g][bj][q], L = pl[g][bj][q]; \
                    const float x0 = __uint_as_float((H << 16) | (L & 0xffffu)), x1 = __uint_as_float((H & 0xffff0000u) | (L >> 16)); \
                    const float a0 = (q < 2) ? acc[ai_][bj][m_][0][2 * q] : acc[ai_][bj][m_][1][2 * q - 4], a1 = (q < 2) ? acc[ai_][bj][m_][0][2 * q + 1] : acc[ai_][bj][m_][1][2 * q - 3]; \
                    ob_[2 * q] = __float_as_uint(x0 + a0); ob_[2 * q + 1] = __float_as_uint(x1 + a1); } \
                _Pragma("unroll") for (int k = 0; k < 8; ++k) { const float t = __uint_as_float(ob_[k] & 0xffff0000u); ss_ += t * t; } \
                if (fin != nullptr) { f32x4 o0, o1; o0[0] = __uint_as_float(ob_[0]); o0[1] = __uint_as_float(ob_[1]); o0[2] = __uint_as_float(ob_[2]); o0[3] = __uint_as_float(ob_[3]); \
                    o1[0] = __uint_as_float(ob_[4]); o1[1] = __uint_as_float(ob_[5]); o1[2] = __uint_as_float(ob_[6]); o1[3] = __uint_as_float(ob_[7]); \
                    *(f32x4*)(fin + off_ + bj * HALF) = o0; *(f32x4*)(fin + off_ + bj * HALF + 4) = o1; } \
                else { u32x4 wh, wl; \
                    wh.x = (ob_[0] >> 16) | (ob_[1] & 0xffff0000u); wh.y = (ob_[2] >> 16) | (ob_[3] & 0xffff0000u); wh.z = (ob_[4] >> 16) | (ob_[5] & 0xffff0000u); wh.w = (ob_[6] >> 16) | (ob_[7] & 0xffff0000u); \
                    wl.x = (ob_[0] & 0xffffu) | (ob_[1] << 16); wl.y = (ob_[2] & 0xffffu) | (ob_[3] << 16); wl.z = (ob_[4] & 0xffffu) | (ob_[5] << 16); wl.w = (ob_[6] & 0xffffu) | (ob_[7] << 16); \
                    *(u32x4*)(hi + off_ + bj * HALF) = wh; *(u32x4*)(lo + off_ + bj * HALF) = wl; } } \
            ss_ += __shfl_xor(ss_, 16); ss_ += __shfl_xor(ss_, 32); \
            if (rowsq_next != nullptr && fq == 0) rowsq_next[(size_t)row_ * 16 + u.pn * 4 + wc] = ss_; } while (0)
        static_assert(HALF * 2 == 256, "bj offset in the asm loads");
        ER_LOAD(0); ER_LOAD(1); ER_LOAD(2);
        ER_WAIT(8, 0); ER_PROC(0); ER_LOAD(3); ER_WAIT(8, 1); ER_PROC(1); ER_LOAD(4); ER_WAIT(8, 2); ER_PROC(2); ER_LOAD(5); ER_WAIT(8, 3); ER_PROC(3); ER_LOAD(6);
        ER_WAIT(8, 4); ER_PROC(4); ER_LOAD(7); ER_WAIT(8, 5); ER_PROC(5); ER_WAIT(4, 6); ER_PROC(6); ER_WAIT(0, 7); ER_PROC(7);
#undef ER_GLD
#undef ER_WAIT
#undef ER_LOAD
#undef ER_PROC
    }
};
template <class Epi, class Sched, bool ALIGN_EPI = false, bool SP2 = false>
__device__ __forceinline__ void gemm_phase(PG8_LAS unsigned char* lds, const Gemm g, const Sched& S, const Epi& E) {
    int tid_ = threadIdx.x; asm volatile("" : "+v"(tid_));
    const int tid = tid_, wid = __builtin_amdgcn_readfirstlane(tid >> 6), lane = tid & 63, wr = wid >> 2, wc = wid & 3, fr = lane & 15, fq = lane >> 4;
    const int K = g.K, nt = K / BK;
    unsigned voffA[2], voffB[2];
#pragma unroll
    for (int i = 0; i < 2; ++i) { int R, C; stage_rc(tid * 16 + i * 8192, R, C); const int Rb = Epi::PERM ? ((R & ~31) + perm32(R & 31)) : R;
        voffA[i] = (unsigned)(R * K + C) * 2u; voffB[i] = (unsigned)(Rb * K + C) * 2u; }
    const size_t kstep = (size_t)(BK * 2);
    const size_t hstep = (size_t)HALF * K * 2;
    const size_t tstep = 2 * hstep;
    const unsigned ldsw = (unsigned)wid * 1024u;
    const int aoff = lds_byte(wr * 64 + fr, fq * 8), boff = lds_byte(wc * 32 + fr, fq * 8);
#define PG8_SA(b, h) (((b) * 2 + (h)) * HTB)
#define PG8_SB(b, h) ((4 + (b) * 2 + (h)) * HTB)
#define PG8_STAGE(bufoff, gbase, voff) do { _Pragma("unroll") for (int _i = 0; _i < 2; ++_i) \
        __builtin_amdgcn_global_load_lds((const unsigned*)((const char*)(gbase) + (voff)[_i]), (PG8_LAS unsigned*)(lds + (bufoff) + ldsw + _i * 8192), 16, 0, 0); } while (0)
#define PG8_LDA(dst, b, h) do { _Pragma("unroll") for (int m = 0; m < 4; ++m) _Pragma("unroll") for (int k = 0; k < 2; ++k) dst[m][k] = *(const PG8_LAS bf16x8*)(lds + PG8_SA(b, h) + aoff + m * 2048 + k * 1024); } while (0)
#define PG8_LDB(dst, b, h) do { _Pragma("unroll") for (int n = 0; n < 2; ++n) _Pragma("unroll") for (int k = 0; k < 2; ++k) dst[n][k] = *(const PG8_LAS bf16x8*)(lds + PG8_SB(b, h) + boff + n * 2048 + k * 1024); } while (0)
#define PG8_MMA(ai, bj, At, Bt) do { __builtin_amdgcn_s_setprio(1); _Pragma("unroll") for (int m = 0; m < 4; ++m) _Pragma("unroll") for (int n = 0; n < 2; ++n) _Pragma("unroll") for (int k = 0; k < 2; ++k) \
        acc[ai][bj][m][n] = __builtin_amdgcn_mfma_f32_16x16x32_bf16(Bt[n][k], At[m][k], acc[ai][bj][m][n], 0, 0, 0); __builtin_amdgcn_s_setprio(0); } while (0)
#define PG8_WAIT_V(n) asm volatile("s_waitcnt vmcnt(" #n ")" ::: "memory")
#define PG8_WAIT_L(n) asm volatile("s_waitcnt lgkmcnt(" #n ")" ::: "memory")
#define PG8_BAR __builtin_amdgcn_s_barrier()
#define PG8_SCHED __builtin_amdgcn_sched_barrier(0)
    Unit cur, nxt; int ui = 0;
    if (!S.next(0, cur)) return;
    f32x4 acc[2][2][4][2];
#pragma unroll
    for (int a = 0; a < 2; ++a)
#pragma unroll
        for (int b = 0; b < 2; ++b)
#pragma unroll
            for (int m = 0; m < 4; ++m)
#pragma unroll
                for (int n = 0; n < 2; ++n) acc[a][b][m][n] = (f32x4){0.f, 0.f, 0.f, 0.f};
    bf16x8 At[4][2], B0[2][2], B1[2][2];
    const char* cA = (const char*)g.A + (size_t)cur.pm * tstep; const char* cB = (const char*)g.Bt + (size_t)cur.pn * tstep;
    S.a_ready(cur);
    if constexpr (SP2) {
        PG8_STAGE(PG8_SB(0, 0), cB, voffB); PG8_STAGE(PG8_SB(0, 1), cB + hstep, voffB); PG8_STAGE(PG8_SA(0, 0), cA, voffA); PG8_STAGE(PG8_SA(0, 1), cA + hstep, voffA);
        if (wr == 1) PG8_BAR;
        PG8_WAIT_V(2); PG8_BAR;
        PG8_STAGE(PG8_SB(1, 0), cB + kstep, voffB); PG8_STAGE(PG8_SA(1, 0), cA + kstep, voffA); PG8_STAGE(PG8_SB(1, 1), cB + hstep + kstep, voffB);
        PG8_WAIT_V(6); PG8_BAR;
    } else {
        PG8_STAGE(PG8_SB(0, 0), cB, voffB); PG8_STAGE(PG8_SA(0, 0), cA, voffA); PG8_STAGE(PG8_SB(0, 1), cB + hstep, voffB); PG8_STAGE(PG8_SA(0, 1), cA + hstep, voffA);
        if (wr == 1) PG8_BAR;
        PG8_WAIT_V(4); PG8_BAR;
        PG8_STAGE(PG8_SB(1, 0), cB + kstep, voffB); PG8_STAGE(PG8_SA(1, 0), cA + kstep, voffA); PG8_STAGE(PG8_SB(1, 1), cB + hstep + kstep, voffB);
        PG8_WAIT_V(6); PG8_BAR;
    }
    for (;;) {
        const bool has_next = S.next(ui + 1, nxt);
        const char* nA = has_next ? (const char*)g.A + (size_t)nxt.pm * tstep : cA; const char* nB = has_next ? (const char*)g.Bt + (size_t)nxt.pn * tstep : cB;
        for (int t = 0; t < nt; t += 2) {
            const bool last = (t == nt - 2);
            const char* a1 = cA + (size_t)(t + 1) * kstep;
            const char* a2 = last ? nA : cA + (size_t)(t + 2) * kstep; const char* b2 = last ? nB : cB + (size_t)(t + 2) * kstep;
            const char* a3 = a2 + kstep; const char* b3 = b2 + kstep;
            if (last && has_next) S.a_ready(nxt);
            if constexpr (SP2) {
            PG8_LDB(B0, 0, 0); PG8_LDB(B1, 0, 1); PG8_SCHED; PG8_LDA(At, 0, 0); PG8_STAGE(PG8_SA(1, 1), a1 + hstep, voffA);
            PG8_WAIT_V(8); PG8_WAIT_L(0); PG8_BAR; PG8_MMA(0, 0, At, B0); PG8_MMA(0, 1, At, B1); PG8_BAR; PG8_SCHED;
            PG8_LDA(At, 0, 1); PG8_STAGE(PG8_SB(0, 0), b2, voffB); PG8_STAGE(PG8_SB(0, 1), b2 + hstep, voffB); PG8_STAGE(PG8_SA(0, 0), a2, voffA);
            PG8_WAIT_V(8); PG8_WAIT_L(0); PG8_BAR; PG8_MMA(1, 0, At, B0); PG8_MMA(1, 1, At, B1); PG8_BAR; PG8_SCHED;
            PG8_LDB(B0, 1, 0); PG8_LDB(B1, 1, 1); PG8_SCHED; PG8_LDA(At, 1, 0); PG8_STAGE(PG8_SA(0, 1), a2 + hstep, voffA);
            PG8_WAIT_V(8); PG8_WAIT_L(0); PG8_BAR; PG8_MMA(0, 0, At, B0); PG8_MMA(0, 1, At, B1); PG8_BAR; PG8_SCHED;
            PG8_LDA(At, 1, 1); PG8_STAGE(PG8_SB(1, 0), b3, voffB); PG8_STAGE(PG8_SB(1, 1), b3 + hstep, voffB); PG8_STAGE(PG8_SA(1, 0), a3, voffA);
            PG8_WAIT_V(8); PG8_WAIT_L(0); PG8_BAR; PG8_MMA(1, 0, At, B0); PG8_MMA(1, 1, At, B1); PG8_BAR; PG8_SCHED;
            } else {
            PG8_LDB(B0, 0, 0); PG8_SCHED; PG8_LDA(At, 0, 0); PG8_STAGE(PG8_SA(1, 1), a1 + hstep, voffA);
            PG8_WAIT_L(8); PG8_BAR; PG8_WAIT_L(0); PG8_MMA(0, 0, At, B0); PG8_BAR; PG8_SCHED;
            PG8_LDB(B1, 0, 1); PG8_STAGE(PG8_SB(0, 0), b2, voffB);
            PG8_BAR; PG8_WAIT_L(0); PG8_MMA(0, 1, At, B1); PG8_BAR;
            PG8_LDA(At, 0, 1); PG8_STAGE(PG8_SA(0, 0), a2, voffA);
            PG8_BAR; PG8_WAIT_L(0); PG8_MMA(1, 0, At, B0); PG8_BAR; PG8_SCHED;
            PG8_STAGE(PG8_SB(0, 1), b2 + hstep, voffB);
            PG8_WAIT_V(6); PG8_BAR; PG8_MMA(1, 1, At, B1); PG8_BAR;
            PG8_LDB(B0, 1, 0); PG8_SCHED; PG8_LDA(At, 1, 0); PG8_STAGE(PG8_SA(0, 1), a2 + hstep, voffA);
            PG8_WAIT_L(8); PG8_BAR; PG8_WAIT_L(0); PG8_MMA(0, 0, At, B0); PG8_BAR; PG8_SCHED;
            PG8_LDB(B1, 1, 1); PG8_STAGE(PG8_SB(1, 0), b3, voffB);
            PG8_BAR; PG8_WAIT_L(0); PG8_MMA(0, 1, At, B1); PG8_BAR;
            PG8_LDA(At, 1, 1); PG8_STAGE(PG8_SA(1, 0), a3, voffA);
            PG8_BAR; PG8_WAIT_L(0); PG8_MMA(1, 0, At, B0); PG8_BAR; PG8_SCHED;
            PG8_STAGE(PG8_SB(1, 1), b3 + hstep, voffB);
            PG8_WAIT_V(6); PG8_BAR; PG8_MMA(1, 1, At, B1); PG8_BAR;
            }
        }
        if constexpr (ALIGN_EPI) { if (wr == 0) PG8_BAR; }
        if constexpr (!Epi::AFTER_DRAIN) { E(acc, cur, wr, wc, fr, fq); S.done(cur); }
        if (!has_next) break;
#pragma unroll
        for (int a = 0; a < 2; ++a)
#pragma unroll
            for (int b = 0; b < 2; ++b)
#pragma unroll
                for (int m = 0; m < 4; ++m)
#pragma unroll
                    for (int n = 0; n < 2; ++n) acc[a][b][m][n] = (f32x4){0.f, 0.f, 0.f, 0.f};
        cur = nxt; cA = nA; cB = nB; ++ui;
        if constexpr (ALIGN_EPI) { if (wr == 1) PG8_BAR; }
    }
    PG8_WAIT_V(0);
    if constexpr (!ALIGN_EPI) { if (wr == 0) PG8_BAR; }
    PG8_BAR;
    if constexpr (Epi::AFTER_DRAIN) { E.fused(acc, cur, wr, wc, fr, fq, lds, wid, lane); S.done(cur); }
#undef PG8_SA
#undef PG8_SB
#undef PG8_STAGE
#undef PG8_LDA
#undef PG8_LDB
#undef PG8_MMA
#undef PG8_WAIT_V
#undef PG8_WAIT_L
#undef PG8_BAR
#undef PG8_SCHED
}
}

constexpr int BATCH = 8, SEQ = 4096, DM = 1024, DEPTH = 4, DFF = 4096;
constexpr int M_TOK = BATCH * SEQ;
constexpr int EVEN_IN = 3072, ODD_IN = 1536;
constexpr int NWAVES = 8, NTHREADS = 512;
constexpr int LDS_BYTES = 157696;
constexpr int N_PHASES = 1 + 7 * DEPTH;

constexpr size_t MiB = 1u << 20;
constexpr size_t WS_ROWSQ = 420 * MiB;
constexpr size_t WS_BAR = 1 * MiB;
constexpr size_t WS_WMLP_IN = 2 * MiB;
constexpr size_t WS_WMLP_OUT = 34 * MiB;
constexpr size_t WS_WIN_EVEN = 66 * MiB;
constexpr size_t WS_WOUT_EVEN = 78 * MiB;
constexpr size_t WS_WIN_ODD = 82 * MiB;
constexpr size_t WS_WOUT_ODD = 88 * MiB;
constexpr size_t WS_COS = 92 * MiB, WS_SIN = 96 * MiB;
constexpr size_t WS_XB = 100 * MiB;
constexpr size_t WS_Z = 164 * MiB;
constexpr size_t WS_Y = 356 * MiB;
constexpr size_t WS_HID = 164 * MiB;
constexpr size_t WS_LO = 436 * MiB;
constexpr size_t OUT_HU = 0, OUT_HQT = 64 * MiB, OUT_HOI = 96 * MiB;
constexpr size_t WS_HDL = 500 * MiB;
constexpr size_t WS_END = 501 * MiB;

typedef unsigned short bf16_t;
typedef short bf16x8 __attribute__((ext_vector_type(8)));
typedef float f32x4 __attribute__((ext_vector_type(4)));
typedef unsigned u32x4 __attribute__((ext_vector_type(4)));
typedef unsigned u32x2 __attribute__((ext_vector_type(2)));
#define LAS __attribute__((address_space(3)))
#define MFMA16(a, b, c) __builtin_amdgcn_mfma_f32_16x16x32_bf16((a), (b), (c), 0, 0, 0)

__device__ __forceinline__ float bf2f(unsigned u) { return __uint_as_float(u << 16); }
__device__ __forceinline__ float bflo(unsigned u) { return __uint_as_float(u << 16); }
__device__ __forceinline__ float bfhi(unsigned u) { return __uint_as_float(u & 0xffff0000u); }
__device__ __forceinline__ unsigned f2bf(float f) { unsigned u = __float_as_uint(f); return (u + 0x7fffu + ((u >> 16) & 1u)) >> 16; }
__device__ __forceinline__ unsigned pk2(float lo, float hi) { return f2bf(lo) | (f2bf(hi) << 16); }
__device__ __forceinline__ float wave_sum(float v) {
#pragma unroll
    for (int o = 1; o < 64; o <<= 1) v += __shfl_xor(v, o);
    return v;
}
__device__ __forceinline__ float red16_sum(float v) { v += __shfl_xor(v, 1); v += __shfl_xor(v, 2); v += __shfl_xor(v, 4); v += __shfl_xor(v, 8); return v; }
__device__ __forceinline__ float red16_max(float v) { v = fmaxf(v, __shfl_xor(v, 1)); v = fmaxf(v, __shfl_xor(v, 2)); v = fmaxf(v, __shfl_xor(v, 4)); v = fmaxf(v, __shfl_xor(v, 8)); return v; }
__device__ __forceinline__ bf16x8 ldfrag(const bf16_t* p) { return *(const bf16x8*)p; }

struct Args {
    const float* in[22]; const int* pos; float* out; unsigned char* ws; int ph_lo, ph_hi;
};

__device__ __forceinline__ void p0_transpose_item(const float* W, int K, int N, bf16_t* WT, const float* gain, float* scr, int item, int lane) {
    const int nblk = N / 64, kb = item / nblk, nb = item % nblk, k0 = 64 * kb, n0 = 64 * nb;
    const int c4 = (lane & 15) * 4;
#pragma unroll 8
    for (int i = 0; i < 16; ++i) { const int kk = 4 * i + (lane >> 4); const float g = gain ? gain[k0 + kk] : 1.0f;
        const f32x4 v = *(const f32x4*)(W + (size_t)(k0 + kk) * N + n0 + c4);
        float* d = scr + kk * 65 + c4; d[0] = v[0] * g; d[1] = v[1] * g; d[2] = v[2] * g; d[3] = v[3] * g; }
    asm volatile("s_waitcnt lgkmcnt(0)" ::: "memory");
    const int c = lane & 7;
#pragma unroll
    for (int j = 0; j < 8; ++j) { const int n = (lane >> 3) + 8 * j; const float* s = scr + (8 * c) * 65 + n;
        u32x4 o; o.x = pk2(s[0 * 65], s[1 * 65]); o.y = pk2(s[2 * 65], s[3 * 65]); o.z = pk2(s[4 * 65], s[5 * 65]); o.w = pk2(s[6 * 65], s[7 * 65]);
        *(u32x4*)(WT + (size_t)(n0 + n) * K + k0 + 8 * c) = o; }
    asm volatile("s_waitcnt lgkmcnt(0)" ::: "memory");
}

__device__ __forceinline__ void p0_prologue(const Args& a, unsigned char* lds) {
    int tid_ = threadIdx.x; asm volatile("" : "+v"(tid_));
    const int tid = tid_, lane = tid & 63, wave = tid >> 6;
    const int G = gridDim.x, bid = blockIdx.x;
    const int gw = bid * NWAVES + wave, NGW = G * NWAVES;
    const int gt = bid * NTHREADS + tid, NGT = G * NTHREADS;
    unsigned char* ws = a.ws;
    float* scr = (float*)(lds + wave * 17408);
    const float* norm_mix = a.in[2]; const float* norm_mlp = a.in[3];
    constexpr int NITEMS = 4 * 2048 + 2 * 1024 + 2 * 640;
    for (int it0 = gw; it0 < NITEMS; it0 += NGW) {
        int it = it0;
        if (it < 8192) { const int l = it >> 11, r = it & 2047;
            if (r < 1024) p0_transpose_item(a.in[4] + (size_t)l * DM * DFF, DM, DFF, (bf16_t*)(ws + WS_WMLP_IN) + (size_t)l * DM * DFF, norm_mlp + l * DM, scr, r, lane);
            else p0_transpose_item(a.in[5] + (size_t)l * DM * DFF, DFF, DM, (bf16_t*)(ws + WS_WMLP_OUT) + (size_t)l * DM * DFF, nullptr, scr, r - 1024, lane);
            continue; }
        it -= 8192;
        if (it < 2048) { const int e = it >> 10, r = it & 1023;
            if (r < 768) p0_transpose_item(a.in[6] + (size_t)e * DM * EVEN_IN, DM, EVEN_IN, (bf16_t*)(ws + WS_WIN_EVEN) + (size_t)e * DM * EVEN_IN, norm_mix + (2 * e) * DM, scr, r, lane);
            else p0_transpose_item(a.in[7] + (size_t)e * DM * DM, DM, DM, (bf16_t*)(ws + WS_WOUT_EVEN) + (size_t)e * DM * DM, nullptr, scr, r - 768, lane);
            continue; }
        it -= 2048;
        { const int o = it / 640, r = it % 640;
            if (r < 384) p0_transpose_item(a.in[17] + (size_t)o * DM * ODD_IN, DM, ODD_IN, (bf16_t*)(ws + WS_WIN_ODD) + (size_t)o * DM * ODD_IN, norm_mix + (2 * o + 1) * DM, scr, r, lane);
            else p0_transpose_item(a.in[18] + (size_t)o * DM * DM, DM, DM, (bf16_t*)(ws + WS_WOUT_ODD) + (size_t)o * DM * DM, nullptr, scr, r - 384, lane); }
    }
    { const float* x = a.in[0]; bf16_t* xb = (bf16_t*)(ws + WS_XB); bf16_t* xl = (bf16_t*)(ws + WS_LO); float* rq0 = (float*)(ws + WS_ROWSQ);
      const bool xa = (G == 256);
      for (int m = xa ? ((bid & 7) * 4096 + 2 * ((bid >> 3) * 8 + wave)) : 2 * gw; m < (xa ? (bid & 7) * 4096 + 4096 : M_TOK); m += (xa ? 512 : 2 * NGW)) {
          const u32x4* xr = (const u32x4*)(x + (size_t)m * DM) + lane; u32x2* oh = (u32x2*)(xb + (size_t)m * DM) + lane; u32x2* ol = (u32x2*)(xl + (size_t)m * DM) + lane;
          u32x4 v[8];
#pragma unroll
          for (int j = 0; j < 8; ++j) v[j] = xr[64 * j];
          float s0 = 0.f, s1 = 0.f;
#pragma unroll
          for (int j = 0; j < 8; ++j) { const float t0 = __uint_as_float(v[j][0] & 0xffff0000u), t1 = __uint_as_float(v[j][1] & 0xffff0000u), t2 = __uint_as_float(v[j][2] & 0xffff0000u), t3 = __uint_as_float(v[j][3] & 0xffff0000u);
              const float q = (t0 * t0 + t1 * t1) + (t2 * t2 + t3 * t3); if (j < 4) s0 += q; else s1 += q;
              u32x2 wh, wl; wh.x = (v[j][0] >> 16) | (v[j][1] & 0xffff0000u); wh.y = (v[j][2] >> 16) | (v[j][3] & 0xffff0000u);
              wl.x = (v[j][0] & 0xffffu) | (v[j][1] << 16); wl.y = (v[j][2] & 0xffffu) | (v[j][3] << 16); oh[64 * j] = wh; ol[64 * j] = wl; }
          s0 = wave_sum(s0); s1 = wave_sum(s1);
          if (lane < 32) rq0[(size_t)m * 16 + lane] = (lane == 0) ? s0 : ((lane == 16) ? s1 : 0.f); } }
    { float* cs = (float*)(ws + WS_COS); float* sn = (float*)(ws + WS_SIN);
      for (int i = gt; i < M_TOK * 32; i += NGT) { const int tok = i >> 5, j = i & 31;
          const float invf = exp2f(-(float)j * (13.287712379549449f / 32.0f));
          const float ang = (float)a.pos[tok] * invf;
          double rev = (double)ang * 0.15915494309189535; rev -= rint(rev);
          const float fr = (float)rev;
          sn[i] = __builtin_amdgcn_sinf(fr); cs[i] = __builtin_amdgcn_cosf(fr); } }
}

#define LBAR() asm volatile("s_waitcnt lgkmcnt(0)\n\ts_barrier" ::: "memory")
typedef float f32x2_t __attribute__((ext_vector_type(2))); typedef __bf16 bf16x2_t __attribute__((ext_vector_type(2)));
__device__ __forceinline__ unsigned cvtpk(float lo, float hi) { f32x2_t v = {lo, hi}; bf16x2_t b = __builtin_convertvector(v, bf16x2_t); return __builtin_bit_cast(unsigned, b); }
__device__ __forceinline__ bf16_t cvt1(float v) { return (bf16_t)(cvtpk(v, 0.f) & 0xffffu); }
__device__ __forceinline__ void hgrn_s1(unsigned char* lds, int it0, int step, int iend, const bf16_t* z, unsigned char* ws, unsigned char* hb, const float* lb_logits, int e_layer) {
    int tid_ = threadIdx.x; asm volatile("" : "+v"(tid_));
    const int tid = tid_, lane = tid & 63, w = tid >> 6, l15 = lane & 15, lg = lane >> 4;
    bf16_t* Qm = (bf16_t*)(lds + 0);
    bf16_t* Km = (bf16_t*)(lds + 17408);
    bf16_t* Qt = (bf16_t*)(lds + 34816);
    bf16_t* KdT = (bf16_t*)(lds + 52224);
    bf16_t* vT = (bf16_t*)(lds + 70656);
    bf16_t* P = (bf16_t*)(lds + 123904);
    float* segtot = (float*)(lds + 133120);
    bf16_t* QT = (bf16_t*)(hb + OUT_HQT); bf16_t* HU = (bf16_t*)(hb + OUT_HU); bf16_t* OI = (bf16_t*)(hb + OUT_HOI); float* DL = (float*)(ws + WS_HDL);
    const int tt = w >> 1, eh = w & 1;
    u32x4 rq[2], rf[2], rv[2];
    int it = it0;
    if (it < iend) { const size_t row0 = (size_t)(it >> 8) * SEQ + 64 * (it & 63); const int h = (it >> 6) & 3;
#pragma unroll
        for (int i = 0; i < 2; ++i) { const int idx = tid + 512 * i, r = idx >> 4, ch = idx & 15; const bf16_t* p = z + (row0 + r) * EVEN_IN + h * 128 + ch * 8;
            rq[i] = *(const u32x4*)p; rf[i] = *(const u32x4*)(p + 512);
            const int rv_r = idx & 63, rv_ch = idx >> 6; rv[i] = *(const u32x4*)(z + (row0 + rv_r) * EVEN_IN + 1024 + h * 128 + rv_ch * 8); } }
    for (; it < iend; it += step) {
        const int h = (it >> 6) & 3;
        const int c0 = h * 128 + 2 * lane;
        float lb0 = 0.f, lb1 = 0.f;
        if (e_layer == 1) { lb0 = 1.0f / (1.0f + __expf(lb_logits[c0] - lb_logits[512 + c0])); lb1 = 1.0f / (1.0f + __expf(lb_logits[c0 + 1] - lb_logits[512 + c0 + 1])); }
        const float om0 = 1.0f - lb0, om1 = 1.0f - lb1;
#pragma unroll
        for (int i = 0; i < 2; ++i) { const int idx = tid + 512 * i, r = idx >> 4, ch = idx & 15;
            *(u32x4*)(Qm + r * 136 + ch * 8) = rq[i]; *(u32x4*)(Km + r * 136 + ch * 8) = rf[i];
            const int vr = idx & 63, vch = idx >> 6; const u32x4 v = rv[i];
            vT[(vch * 8 + 0) * 72 + vr] = (bf16_t)(v.x & 0xffffu); vT[(vch * 8 + 1) * 72 + vr] = (bf16_t)(v.x >> 16);
            vT[(vch * 8 + 2) * 72 + vr] = (bf16_t)(v.y & 0xffffu); vT[(vch * 8 + 3) * 72 + vr] = (bf16_t)(v.y >> 16);
            vT[(vch * 8 + 4) * 72 + vr] = (bf16_t)(v.z & 0xffffu); vT[(vch * 8 + 5) * 72 + vr] = (bf16_t)(v.z >> 16);
            vT[(vch * 8 + 6) * 72 + vr] = (bf16_t)(v.w & 0xffffu); vT[(vch * 8 + 7) * 72 + vr] = (bf16_t)(v.w >> 16); }
        if (it + step < iend) { const int nx = it + step; const size_t row0 = (size_t)(nx >> 8) * SEQ + 64 * (nx & 63); const int hn = (nx >> 6) & 3;
#pragma unroll
            for (int i = 0; i < 2; ++i) { const int idx = tid + 512 * i, r = idx >> 4, ch = idx & 15; const bf16_t* p = z + (row0 + r) * EVEN_IN + hn * 128 + ch * 8;
                rq[i] = *(const u32x4*)p; rf[i] = *(const u32x4*)(p + 512);
                const int rv_r = idx & 63, rv_ch = idx >> 6; rv[i] = *(const u32x4*)(z + (row0 + rv_r) * EVEN_IN + 1024 + hn * 128 + rv_ch * 8); } }
        LBAR();
        float kk0[8], kk1[8], bl0[8], bl1[8]; float cum0 = 0.f, cum1 = 0.f;
#pragma unroll
        for (int i = 0; i < 8; ++i) { const int t = 8 * w + i; const unsigned fx2 = *(const unsigned*)(Km + t * 136 + 2 * lane);
            const float fx0 = bflo(fx2), fx1 = bfhi(fx2);
            const float e0 = __expf(-fx0), e1 = __expf(-fx1); const float s0 = __builtin_amdgcn_rcpf(1.0f + e0), s1 = __builtin_amdgcn_rcpf(1.0f + e1);
            const float f0 = lb0 + om0 * s0, f1 = lb1 + om1 * s1;
            cum0 += __logf(fmaxf(f0, 1e-30f)); cum1 += __logf(fmaxf(f1, 1e-30f));
            bl0[i] = cum0; bl1[i] = cum1; kk0[i] = om0 * e0 * s0; kk1[i] = om1 * e1 * s1; }
        segtot[w * 128 + 2 * lane] = cum0; segtot[w * 128 + 2 * lane + 1] = cum1;
        LBAR();
        float off0 = 0.f, off1 = 0.f, mid0 = 0.f, mid1 = 0.f, la0 = 0.f, la1 = 0.f;
#pragma unroll
        for (int s = 0; s < 8; ++s) { const float a0 = segtot[s * 128 + 2 * lane], a1 = segtot[s * 128 + 2 * lane + 1];
            if (s < w) { off0 += a0; off1 += a1; } if (s < 4) { mid0 += a0; mid1 += a1; } la0 += a0; la1 += a1; }
        const float em0 = __expf(mid0), em1 = __expf(mid1), elm0 = __expf(la0 - mid0), elm1 = __expf(la1 - mid1);
        unsigned kd0[4], kd1[4]; float kdprev0 = 0.f, kdprev1 = 0.f;
#pragma unroll
        for (int i = 0; i < 8; ++i) { const int t = 8 * w + i; const unsigned q2 = *(const unsigned*)(Qm + t * 136 + 2 * lane);
            const float q0 = bflo(q2), q1 = bfhi(q2); const float b0 = off0 + bl0[i], b1 = off1 + bl1[i];
            const float qm0 = q0 * __expf(fminf(b0 - mid0, 80.f)), qm1 = q1 * __expf(fminf(b1 - mid1, 80.f));
            const float km0 = kk0[i] * __expf(fminf(mid0 - b0, 80.f)), km1 = kk1[i] * __expf(fminf(mid1 - b1, 80.f));
            const float qt0 = qm0 * em0, qt1 = qm1 * em1;
            const float kdv0 = km0 * elm0, kdv1 = km1 * elm1;
            *(unsigned*)(Qm + t * 136 + 2 * lane) = cvtpk(qm0, qm1); *(unsigned*)(Km + t * 136 + 2 * lane) = cvtpk(km0, km1); *(unsigned*)(Qt + t * 136 + 2 * lane) = cvtpk(qt0, qt1);
            if (i & 1) { kd0[i >> 1] = cvtpk(kdprev0, kdv0); kd1[i >> 1] = cvtpk(kdprev1, kdv1); } else { kdprev0 = kdv0; kdprev1 = kdv1; } }
        { u32x4 t0; t0.x = kd0[0]; t0.y = kd0[1]; t0.z = kd0[2]; t0.w = kd0[3]; *(u32x4*)(KdT + (2 * lane) * 72 + 8 * w) = t0;
          u32x4 t1; t1.x = kd1[0]; t1.y = kd1[1]; t1.z = kd1[2]; t1.w = kd1[3]; *(u32x4*)(KdT + (2 * lane + 1) * 72 + 8 * w) = t1; }
        if (w == 0) { f32x2_t dv = {em0 * elm0, em1 * elm1}; *(f32x2_t*)(DL + (size_t)it * 128 + 2 * lane) = dv; }
        LBAR();
#pragma unroll
        for (int sti = 0; sti < 2; ++sti) { const int st = 2 * eh + sti; f32x4 acc = (f32x4){0.f, 0.f, 0.f, 0.f};
            if (st <= tt) {
#pragma unroll
                for (int ks = 0; ks < 4; ++ks) acc = MFMA16(ldfrag(Qm + (16 * tt + l15) * 136 + 32 * ks + 8 * lg), ldfrag(Km + (16 * st + l15) * 136 + 32 * ks + 8 * lg), acc); }
#pragma unroll
            for (int reg = 0; reg < 4; ++reg) { const int t = 16 * tt + 4 * lg + reg, s = 16 * st + l15; const float v = (st <= tt && s <= t) ? acc[reg] : 0.f; P[t * 72 + s] = cvt1(v); } }
        { const bf16x8 a0 = ldfrag(KdT + (16 * w + l15) * 72 + 8 * lg), a1 = ldfrag(KdT + (16 * w + l15) * 72 + 32 + 8 * lg);
#pragma unroll
          for (int j = 0; j < 8; ++j) { f32x4 sv = (f32x4){0.f, 0.f, 0.f, 0.f};
              sv = MFMA16(a0, ldfrag(vT + (16 * j + l15) * 72 + 8 * lg), sv); sv = MFMA16(a1, ldfrag(vT + (16 * j + l15) * 72 + 32 + 8 * lg), sv);
              u32x2 pk; pk.x = cvtpk(sv[0], sv[1]); pk.y = cvtpk(sv[2], sv[3]); *(u32x2*)(HU + (((size_t)it * 8 + w) * 8 + j) * 256 + lane * 4) = pk; } }
#pragma unroll
        for (int i = 0; i < 2; ++i) { const int idx = tid + 512 * i, r = idx >> 4, ch = idx & 15; *(u32x4*)(QT + (size_t)it * 8192 + r * 128 + ch * 8) = *(const u32x4*)(Qt + r * 136 + ch * 8); }
        LBAR();
        { bf16x8 pa[2];
#pragma unroll
          for (int ks = 0; ks < 2; ++ks) pa[ks] = ldfrag(P + (16 * tt + l15) * 72 + 32 * ks + 8 * lg);
#pragma unroll
          for (int j = 0; j < 4; ++j) { const int et = 4 * eh + j; f32x4 acc = (f32x4){0.f, 0.f, 0.f, 0.f};
#pragma unroll
              for (int ks = 0; ks < 2; ++ks) acc = MFMA16(pa[ks], ldfrag(vT + (16 * et + l15) * 72 + 32 * ks + 8 * lg), acc);
              u32x2 pk; pk.x = cvtpk(acc[0], acc[1]); pk.y = cvtpk(acc[2], acc[3]); *(u32x2*)(OI + (((size_t)it * 4 + tt) * 8 + et) * 256 + lane * 4) = pk; } }
        LBAR();
    }
    __syncthreads();
}

struct HgrnSet { u32x4 q[2]; u32x2 u[2]; u32x2 oi; f32x4 dl; };
__device__ __forceinline__ void hgrn_s2_load(HgrnSet& s, int it, const unsigned char* ws, const unsigned char* hb, int tid, int lane, int w, int lg, int tt, int et, int eq) {
    const bf16_t* QT = (const bf16_t*)(hb + OUT_HQT); const bf16_t* HU = (const bf16_t*)(hb + OUT_HU); const bf16_t* OI = (const bf16_t*)(hb + OUT_HOI); const float* DL = (const float*)(ws + WS_HDL);
#pragma unroll
    for (int i = 0; i < 2; ++i) { const int idx = tid + 512 * i, r = idx >> 4, ch = idx & 15; s.q[i] = *(const u32x4*)(QT + (size_t)it * 8192 + r * 128 + ch * 8); }
#pragma unroll
    for (int jj = 0; jj < 2; ++jj) s.u[jj] = *(const u32x2*)(HU + (((size_t)it * 8 + w) * 8 + 2 * eq + jj) * 256 + lane * 4);
    s.oi = *(const u32x2*)(OI + (((size_t)it * 4 + tt) * 8 + 2 * eq + et) * 256 + lane * 4);
    s.dl = *(const f32x4*)(DL + (size_t)it * 128 + 16 * w + 4 * lg);
}
__device__ __forceinline__ void hgrn_s2_chunk(HgrnSet& s, f32x4 (&S)[2], int it, bool more, unsigned char* lds, const unsigned char* ws, const unsigned char* hb, bf16_t* yrow, int tid, int lane, int w, int l15, int lg, int tt, int et, int eq) {
    bf16_t* Qts = (bf16_t*)(lds + 0);
    bf16_t* ST2 = (bf16_t*)(lds + 17408);
    bf16_t* O2s = (bf16_t*)(lds + 26112);
#pragma unroll
    for (int i = 0; i < 2; ++i) { const int idx = tid + 512 * i, r = idx >> 4, ch = idx & 15; *(u32x4*)(Qts + r * 136 + ch * 8) = s.q[i]; }
#pragma unroll
    for (int jj = 0; jj < 2; ++jj) { u32x2 pk; pk.x = cvtpk(S[jj][0], S[jj][1]); pk.y = cvtpk(S[jj][2], S[jj][3]); *(u32x2*)(ST2 + (16 * jj + l15) * 136 + 16 * w + 4 * lg) = pk; }
    const u32x2 u0 = s.u[0], u1 = s.u[1], oi = s.oi; const f32x4 dl = s.dl;
    if (more) hgrn_s2_load(s, it + 4, ws, hb, tid, lane, w, lg, tt, et, eq);
    LBAR();
    f32x4 acc = (f32x4){0.f, 0.f, 0.f, 0.f};
#pragma unroll
    for (int ks = 0; ks < 4; ++ks) acc = MFMA16(ldfrag(Qts + (16 * tt + l15) * 136 + 32 * ks + 8 * lg), ldfrag(ST2 + (16 * et + l15) * 136 + 32 * ks + 8 * lg), acc);
    const float o0 = acc[0] + bflo(oi.x), o1 = acc[1] + bfhi(oi.x), o2 = acc[2] + bflo(oi.y), o3 = acc[3] + bfhi(oi.y);
    O2s[(16 * tt + 4 * lg + 0) * 40 + 16 * et + l15] = cvt1(o0); O2s[(16 * tt + 4 * lg + 1) * 40 + 16 * et + l15] = cvt1(o1);
    O2s[(16 * tt + 4 * lg + 2) * 40 + 16 * et + l15] = cvt1(o2); O2s[(16 * tt + 4 * lg + 3) * 40 + 16 * et + l15] = cvt1(o3);
    S[0][0] = dl[0] * S[0][0] + bflo(u0.x); S[0][1] = dl[1] * S[0][1] + bfhi(u0.x); S[0][2] = dl[2] * S[0][2] + bflo(u0.y); S[0][3] = dl[3] * S[0][3] + bfhi(u0.y);
    S[1][0] = dl[0] * S[1][0] + bflo(u1.x); S[1][1] = dl[1] * S[1][1] + bfhi(u1.x); S[1][2] = dl[2] * S[1][2] + bflo(u1.y); S[1][3] = dl[3] * S[1][3] + bfhi(u1.y);
    LBAR();
    if (tid < 256) { const int r = tid >> 2, ch = tid & 3; *(u32x4*)(yrow + (size_t)r * DM + ch * 8) = *(const u32x4*)(O2s + r * 40 + ch * 8); }
}
__device__ __forceinline__ void hgrn_s2(unsigned char* lds, int blk, const unsigned char* ws, const unsigned char* hb, bf16_t* y) {
    int tid_ = threadIdx.x; asm volatile("" : "+v"(tid_));
    const int tid = tid_, lane = tid & 63, w = tid >> 6, l15 = lane & 15, lg = lane >> 4;
    const int b = blk >> 4, h = (blk >> 2) & 3, eq = blk & 3, tt = w >> 1, et = w & 1;
    const int it0 = (b * 4 + h) * 64;
    f32x4 S[2]; S[0] = (f32x4){0.f, 0.f, 0.f, 0.f}; S[1] = (f32x4){0.f, 0.f, 0.f, 0.f};
    HgrnSet s0, s1, s2, s3;
    hgrn_s2_load(s0, it0 + 0, ws, hb, tid, lane, w, lg, tt, et, eq); hgrn_s2_load(s1, it0 + 1, ws, hb, tid, lane, w, lg, tt, et, eq);
    hgrn_s2_load(s2, it0 + 2, ws, hb, tid, lane, w, lg, tt, et, eq); hgrn_s2_load(s3, it0 + 3, ws, hb, tid, lane, w, lg, tt, et, eq);
    bf16_t* ybase = y + ((size_t)b * SEQ) * DM + h * 128 + 32 * eq;
    for (int c = 0; c < 64; c += 4) {
        const bool more = (c + 4 < 64);
        hgrn_s2_chunk(s0, S, it0 + c + 0, more, lds, ws, hb, ybase + (size_t)(64 * (c + 0)) * DM, tid, lane, w, l15, lg, tt, et, eq);
        hgrn_s2_chunk(s1, S, it0 + c + 1, more, lds, ws, hb, ybase + (size_t)(64 * (c + 1)) * DM, tid, lane, w, l15, lg, tt, et, eq);
        hgrn_s2_chunk(s2, S, it0 + c + 2, more, lds, ws, hb, ybase + (size_t)(64 * (c + 2)) * DM, tid, lane, w, l15, lg, tt, et, eq);
        hgrn_s2_chunk(s3, S, it0 + c + 3, more, lds, ws, hb, ybase + (size_t)(64 * (c + 3)) * DM, tid, lane, w, l15, lg, tt, et, eq);
    }
    __syncthreads();
}

__device__ __forceinline__ void hgrn_s3(int G, int bid, const bf16_t* z, bf16_t* y, const float* gn) {
    int tid_ = threadIdx.x; asm volatile("" : "+v"(tid_));
    const int tid = tid_, lane = tid & 63, wave = tid >> 6;
    const int gw = bid * NWAVES + wave, NGW = G * NWAVES;
    const f32x4 g0 = *(const f32x4*)(gn + lane * 8), g1 = *(const f32x4*)(gn + lane * 8 + 4);
    const bool xa = (G == 256);
    for (int row = xa ? ((bid & 7) * 4096 + (bid >> 3) * 8 + wave) : gw; row < (xa ? (bid & 7) * 4096 + 4096 : M_TOK); row += (xa ? 256 : NGW)) {
        const u32x4 ov = *(const u32x4*)(y + (size_t)row * DM + lane * 8); const u32x4 gv = *(const u32x4*)(z + (size_t)row * EVEN_IN + 1536 + lane * 8);
        float o[8], ga[8];
        o[0] = bflo(ov.x); o[1] = bfhi(ov.x); o[2] = bflo(ov.y); o[3] = bfhi(ov.y); o[4] = bflo(ov.z); o[5] = bfhi(ov.z); o[6] = bflo(ov.w); o[7] = bfhi(ov.w);
        ga[0] = bflo(gv.x); ga[1] = bfhi(gv.x); ga[2] = bflo(gv.y); ga[3] = bfhi(gv.y); ga[4] = bflo(gv.z); ga[5] = bfhi(gv.z); ga[6] = bflo(gv.w); ga[7] = bfhi(gv.w);
        float ss = 0.f;
#pragma unroll
        for (int k = 0; k < 8; ++k) ss += o[k] * o[k];
        ss = red16_sum(ss);
        const float rs = rsqrtf(ss * (1.0f / 128.0f) + 1e-6f);
        float r[8];
#pragma unroll
        for (int k = 0; k < 8; ++k) { const float gk = (k < 4) ? g0[k & 3] : g1[k & 3]; r[k] = o[k] * rs * gk * (ga[k] * __builtin_amdgcn_rcpf(1.0f + __expf(-ga[k]))); }
        u32x4 wv; wv.x = cvtpk(r[0], r[1]); wv.y = cvtpk(r[2], r[3]); wv.z = cvtpk(r[4], r[5]); wv.w = cvtpk(r[6], r[7]);
        *(u32x4*)(y + (size_t)row * DM + lane * 8) = wv;
    }
}

__device__ __forceinline__ void rglru_item(unsigned char* lds, int b, int n, int jq, const bf16_t* z, bf16_t* y, const float* conv_w, const float* conv_b,
                                           const float* wa, const float* ba, const float* wx, const float* bx, const float* lam) {
    int tid_ = threadIdx.x; asm volatile("" : "+v"(tid_));
    const int tid = tid_, lane = tid & 63, w = tid >> 6, l15 = lane & 15, lg = lane >> 4;
    bf16_t* raw = (bf16_t*)(lds);
    bf16_t* Wt = (bf16_t*)(lds + 37440);
    float* G = (float*)(lds + 55872);
    float* AH = (float*)(lds + 89664);
    for (int idx = tid; idx < 4 * 32 * 64; idx += NTHREADS) { const int tap = idx >> 11, jj = (idx >> 6) & 31, i = idx & 63;
        const float v = (jj < 16) ? wa[((size_t)n * 64 + i) * 64 + 16 * jq + jj] : wx[((size_t)n * 64 + i) * 64 + 16 * jq + jj - 16];
        Wt[(tap * 32 + jj) * 72 + i] = cvt1(v * conv_w[tap * 512 + 64 * n + i]); }
    const int j = tid & 15, seg = tid >> 4;
    const int cch = 64 * n + 16 * jq + j;
    float bav = ba[cch], bxv = bx[cch];
    for (int i = 0; i < 64; ++i) { const float cbi = conv_b[64 * n + i]; bav += cbi * wa[((size_t)n * 64 + i) * 64 + 16 * jq + j]; bxv += cbi * wx[((size_t)n * 64 + i) * 64 + 16 * jq + j]; }
    const float c8 = -8.0f * log1pf(expf(-lam[cch]));
    const float cw0 = conv_w[cch], cw1 = conv_w[512 + cch], cw2 = conv_w[1024 + cch], cw3 = conv_w[1536 + cch], cbv = conv_b[cch];
    const int o8 = tid & 7;
    float h_in = 0.f;
    const size_t rowb = (size_t)b * SEQ;
#define RG_GLD(dst, p) asm volatile("global_load_dwordx4 %0, %1, off" : "=v"(dst) : "v"(p) : "memory")
    u32x4 rr[5];
#pragma unroll
    for (int i = 0; i < 5; ++i) { const int idx = tid + 512 * i; const int r = (idx < 259 * 8) ? (idx >> 3) : 258; const int tok = (r >= 3) ? r - 3 : 0;
        const bf16_t* p_ = z + (rowb + tok) * EVEN_IN + 2560 + 64 * n + o8 * 8; RG_GLD(rr[i], p_); }
    for (int tile = 0; tile < 16; ++tile) {
        const int t0 = tile * 256;
        if (tile == 0) { asm volatile("s_waitcnt vmcnt(0)" : "+v"(rr[0]), "+v"(rr[1]), "+v"(rr[2]), "+v"(rr[3]), "+v"(rr[4]) : : "memory"); if (tid < 24) rr[0] = (u32x4){0u, 0u, 0u, 0u}; }
        else asm volatile("s_waitcnt vmcnt(8)" : "+v"(rr[0]), "+v"(rr[1]), "+v"(rr[2]), "+v"(rr[3]), "+v"(rr[4]) : : "memory");
#pragma unroll
        for (int i = 0; i < 5; ++i) { const int idx = tid + 512 * i, r = idx >> 3; if (idx < 259 * 8) *(u32x4*)(raw + r * 72 + o8 * 8) = rr[i]; }
        if (tile + 1 < 16) {
#pragma unroll
            for (int i = 0; i < 5; ++i) { const int idx = tid + 512 * i; const int r = (idx < 259 * 8) ? (idx >> 3) : 258; const bf16_t* p_ = z + (rowb + t0 + 256 - 3 + r) * EVEN_IN + 2560 + 64 * n + o8 * 8; RG_GLD(rr[i], p_); } }
        unsigned gb[8];
#pragma unroll
        for (int i = 0; i < 8; ++i) gb[i] = z[(rowb + t0 + 8 * seg + i) * EVEN_IN + 2048 + cch];
        LBAR();
#pragma unroll
        for (int mi = 0; mi < 2; ++mi) { const int mt = 2 * w + mi;
            f32x4 acc0 = (f32x4){0.f, 0.f, 0.f, 0.f}, acc1 = (f32x4){0.f, 0.f, 0.f, 0.f};
#pragma unroll
            for (int tap = 0; tap < 4; ++tap) {
                const bf16x8 a0 = ldfrag(raw + (16 * mt + l15 + tap) * 72 + 8 * lg), a1 = ldfrag(raw + (16 * mt + l15 + tap) * 72 + 32 + 8 * lg);
                acc0 = MFMA16(a0, ldfrag(Wt + (tap * 32 + l15) * 72 + 8 * lg), acc0); acc0 = MFMA16(a1, ldfrag(Wt + (tap * 32 + l15) * 72 + 32 + 8 * lg), acc0);
                acc1 = MFMA16(a0, ldfrag(Wt + (tap * 32 + 16 + l15) * 72 + 8 * lg), acc1); acc1 = MFMA16(a1, ldfrag(Wt + (tap * 32 + 16 + l15) * 72 + 32 + 8 * lg), acc1); }
#pragma unroll
            for (int reg = 0; reg < 4; ++reg) { G[(16 * mt + 4 * lg + reg) * 33 + l15] = acc0[reg]; G[(16 * mt + 4 * lg + reg) * 33 + 16 + l15] = acc1[reg]; } }
        LBAR();
        float av[8], uv[8]; float Ac = 1.f, Hc = 0.f;
#pragma unroll
        for (int i = 0; i < 8; ++i) { const int t = 8 * seg + i;
            const float gr = G[t * 33 + j] + bav, gi = G[t * 33 + 16 + j] + bxv;
            const float r = __builtin_amdgcn_rcpf(1.0f + __expf(-gr)), ig = __builtin_amdgcn_rcpf(1.0f + __expf(-gi));
            const float la = c8 * r; const float aa = __expf(la); const float t2 = 2.0f * la;
            const float om = (t2 > -0.02f) ? -(t2 + 0.5f * t2 * t2 + 0.16666667f * t2 * t2 * t2) : (1.0f - aa * aa);
            const float m2 = __builtin_amdgcn_sqrtf(fmaxf(om, 0.f));
            const int cl = 16 * jq + j;
            const float xf = cbv + cw0 * bf2f(raw[(t + 0) * 72 + cl]) + cw1 * bf2f(raw[(t + 1) * 72 + cl]) + cw2 * bf2f(raw[(t + 2) * 72 + cl]) + cw3 * bf2f(raw[(t + 3) * 72 + cl]);
            const float u = m2 * (ig * xf);
            av[i] = aa; uv[i] = u; Ac *= aa; Hc = aa * Hc + u; }
        AH[(seg * 16 + j) * 2] = Ac; AH[(seg * 16 + j) * 2 + 1] = Hc;
        LBAR();
        float cur = h_in, hs = 0.f;
#pragma unroll
        for (int s = 0; s < 32; ++s) { const f32x2_t ah = *(const f32x2_t*)(AH + (s * 16 + j) * 2); if (s == seg) hs = cur; cur = ah.x * cur + ah.y; }
        float hh = hs;
#pragma unroll
        for (int i = 0; i < 8; ++i) { hh = av[i] * hh + uv[i]; const float g = bf2f(gb[i]);
            const float u = 0.7978845608028654f * (g + 0.044715f * g * g * g); const float th = 1.0f - 2.0f * __builtin_amdgcn_rcpf(1.0f + __expf(2.0f * u));
            const float ge = 0.5f * g * (1.0f + th);
            y[(rowb + t0 + 8 * seg + i) * DM + 512 + cch] = cvt1(hh * ge); }
        h_in = cur;
    }
    __syncthreads();
}

__device__ __forceinline__ void qk_rot(const u32x4 r1, const u32x4 r2, const f32x4 g1a, const f32x4 g1b, const f32x4 g2a, const f32x4 g2b, const f32x4 ca, const f32x4 cb, const f32x4 sa, const f32x4 sb, int p, float scale, bf16_t* dst) {
    float x1[8], x2[8];
    x1[0] = bflo(r1.x); x1[1] = bfhi(r1.x); x1[2] = bflo(r1.y); x1[3] = bfhi(r1.y); x1[4] = bflo(r1.z); x1[5] = bfhi(r1.z); x1[6] = bflo(r1.w); x1[7] = bfhi(r1.w);
    x2[0] = bflo(r2.x); x2[1] = bfhi(r2.x); x2[2] = bflo(r2.y); x2[3] = bfhi(r2.y); x2[4] = bflo(r2.z); x2[5] = bfhi(r2.z); x2[6] = bflo(r2.w); x2[7] = bfhi(r2.w);
    float ss = 0.f;
#pragma unroll
    for (int i = 0; i < 8; ++i) ss += x1[i] * x1[i] + x2[i] * x2[i];
    ss += __shfl_xor(ss, 1); ss += __shfl_xor(ss, 2);
    const float rs = rsqrtf(ss * (1.0f / 64.0f) + 1e-6f) * scale;
    float o1[8], o2[8];
#pragma unroll
    for (int i = 0; i < 8; ++i) { const float c = (i < 4) ? ca[i & 3] : cb[i & 3], sn = (i < 4) ? sa[i & 3] : sb[i & 3];
        const float g1 = (i < 4) ? g1a[i & 3] : g1b[i & 3], g2 = (i < 4) ? g2a[i & 3] : g2b[i & 3];
        const float y1 = x1[i] * rs * g1, y2 = x2[i] * rs * g2;
        o1[i] = y1 * c - y2 * sn; o2[i] = y2 * c + y1 * sn; }
    u32x4 w1, w2; w1.x = cvtpk(o1[0], o1[1]); w1.y = cvtpk(o1[2], o1[3]); w1.z = cvtpk(o1[4], o1[5]); w1.w = cvtpk(o1[6], o1[7]);
    w2.x = cvtpk(o2[0], o2[1]); w2.y = cvtpk(o2[2], o2[3]); w2.z = cvtpk(o2[4], o2[5]); w2.w = cvtpk(o2[6], o2[7]);
    *(u32x4*)(dst + 8 * p) = w1; *(u32x4*)(dst + 32 + 8 * p) = w2;
}

__device__ __forceinline__ void swa_item(unsigned char* lds, int b, int n, int kvh, const bf16_t* z, bf16_t* y, const float* cosT, const float* sinT,
                                         const float* qn, const float* kn, const float* sinks) {
    int tid_ = threadIdx.x; asm volatile("" : "+v"(tid_));
    const int tid = tid_, lane = tid & 63, w = tid >> 6, l15 = lane & 15, lg = lane >> 4;
    bf16_t* Ks = (bf16_t*)lds;
    bf16_t* VT = (bf16_t*)(lds + 36864);
    bf16_t* Qs = (bf16_t*)(lds + 72704);
    bf16_t* Pw = (bf16_t*)(lds + 91136) + w * (16 * 168);
    const size_t tok0 = (size_t)b * SEQ + 128 * n;
    const int prow = tid >> 2, pp = tid & 3;
    const bool first = (n == 0);
    const u32x4 zz = (u32x4){0u, 0u, 0u, 0u}; const f32x4 zf = (f32x4){0.f, 0.f, 0.f, 0.f};
    u32x4 k0a = zz, k0b = zz; f32x4 c0a = zf, c0b = zf, s0a = zf, s0b = zf;
    if (!first) { const size_t tok = tok0 - 128 + prow; const bf16_t* kp = z + tok * ODD_IN + 1024 + kvh * 64;
        k0a = *(const u32x4*)(kp + 8 * pp); k0b = *(const u32x4*)(kp + 32 + 8 * pp);
        c0a = *(const f32x4*)(cosT + tok * 32 + 8 * pp); c0b = *(const f32x4*)(cosT + tok * 32 + 8 * pp + 4); s0a = *(const f32x4*)(sinT + tok * 32 + 8 * pp); s0b = *(const f32x4*)(sinT + tok * 32 + 8 * pp + 4); }
    const size_t tokq = tok0 + prow;
    const bf16_t* kp1 = z + tokq * ODD_IN + 1024 + kvh * 64;
    const u32x4 k1a = *(const u32x4*)(kp1 + 8 * pp), k1b = *(const u32x4*)(kp1 + 32 + 8 * pp);
    const f32x4 c1a = *(const f32x4*)(cosT + tokq * 32 + 8 * pp), c1b = *(const f32x4*)(cosT + tokq * 32 + 8 * pp + 4), s1a = *(const f32x4*)(sinT + tokq * 32 + 8 * pp), s1b = *(const f32x4*)(sinT + tokq * 32 + 8 * pp + 4);
    u32x4 vv[4];
#pragma unroll
    for (int i = 0; i < 4; ++i) { const int idx = tid + 512 * i, r = idx & 255, c8 = idx >> 8; vv[i] = zz;
        if (!(first && r < 128)) vv[i] = *(const u32x4*)(z + (tok0 - 128 + r) * ODD_IN + 1280 + kvh * 64 + c8 * 8); }
    const f32x4 kg1a = *(const f32x4*)(kn + 8 * pp), kg1b = *(const f32x4*)(kn + 8 * pp + 4), kg2a = *(const f32x4*)(kn + 32 + 8 * pp), kg2b = *(const f32x4*)(kn + 32 + 8 * pp + 4);
    f32x4 qg1a = *(const f32x4*)(qn + 8 * pp), qg1b = *(const f32x4*)(qn + 8 * pp + 4), qg2a = *(const f32x4*)(qn + 32 + 8 * pp), qg2b = *(const f32x4*)(qn + 32 + 8 * pp + 4);
    float sinkv[4];
#pragma unroll
    for (int g = 0; g < 4; ++g) sinkv[g] = sinks[kvh * 4 + g];
    u32x4 qa_[4], qb_[4];
#pragma unroll
    for (int g = 0; g < 4; ++g) { const bf16_t* qp = z + tokq * ODD_IN + (kvh * 4 + g) * 64; qa_[g] = *(const u32x4*)(qp + 8 * pp); qb_[g] = *(const u32x4*)(qp + 32 + 8 * pp); }
    if (first) { *(u32x4*)(Ks + prow * 72 + 8 * pp) = zz; *(u32x4*)(Ks + prow * 72 + 32 + 8 * pp) = zz; }
    else qk_rot(k0a, k0b, kg1a, kg1b, kg2a, kg2b, c0a, c0b, s0a, s0b, pp, 1.0f, Ks + prow * 72);
    qk_rot(k1a, k1b, kg1a, kg1b, kg2a, kg2b, c1a, c1b, s1a, s1b, pp, 1.0f, Ks + (128 + prow) * 72);
#pragma unroll
    for (int i = 0; i < 4; ++i) { const int idx = tid + 512 * i, r = idx & 255, c8 = idx >> 8; const u32x4 v = vv[i];
        VT[(c8 * 8 + 0) * 280 + r] = (bf16_t)(v.x & 0xffffu); VT[(c8 * 8 + 1) * 280 + r] = (bf16_t)(v.x >> 16);
        VT[(c8 * 8 + 2) * 280 + r] = (bf16_t)(v.y & 0xffffu); VT[(c8 * 8 + 3) * 280 + r] = (bf16_t)(v.y >> 16);
        VT[(c8 * 8 + 4) * 280 + r] = (bf16_t)(v.z & 0xffffu); VT[(c8 * 8 + 5) * 280 + r] = (bf16_t)(v.z >> 16);
        VT[(c8 * 8 + 6) * 280 + r] = (bf16_t)(v.w & 0xffffu); VT[(c8 * 8 + 7) * 280 + r] = (bf16_t)(v.w >> 16); }
    for (int idx = tid; idx < 64 * 24; idx += NTHREADS) VT[(idx / 24) * 280 + 256 + (idx % 24)] = 0;
    asm volatile("s_waitcnt vmcnt(0)" : "+v"(qa_[0]), "+v"(qa_[1]), "+v"(qa_[2]), "+v"(qa_[3]), "+v"(qb_[0]), "+v"(qb_[1]), "+v"(qb_[2]), "+v"(qb_[3]), "+v"(qg1a), "+v"(qg1b), "+v"(qg2a), "+v"(qg2b) : : "memory");
    asm volatile("" : "+v"(sinkv[0]), "+v"(sinkv[1]), "+v"(sinkv[2]), "+v"(sinkv[3]));
#pragma unroll
    for (int g = 0; g < 4; ++g) {
        const int hq = kvh * 4 + g;
        LBAR();
        qk_rot(qa_[g], qb_[g], qg1a, qg1b, qg2a, qg2b, c1a, c1b, s1a, s1b, pp, 0.125f, Qs + prow * 72);
        LBAR();
        const float sink = sinkv[g];
        const bf16x8 qf0 = ldfrag(Qs + (16 * w + l15) * 72 + 8 * lg), qf1 = ldfrag(Qs + (16 * w + l15) * 72 + 32 + 8 * lg);
        f32x4 sc[9];
#pragma unroll
        for (int kt = 0; kt < 9; ++kt) { const int kr = 16 * (w + kt) + l15; f32x4 acc = (f32x4){0.f, 0.f, 0.f, 0.f};
            acc = MFMA16(ldfrag(Ks + kr * 72 + 8 * lg), qf0, acc); acc = MFMA16(ldfrag(Ks + kr * 72 + 32 + 8 * lg), qf1, acc); sc[kt] = acc; }
        float m = -1e30f;
#pragma unroll
        for (int kt = 0; kt < 9; ++kt) {
            const bool tile_ok = !first || (w + kt >= 8);
#pragma unroll
            for (int reg = 0; reg < 4; ++reg) { const int dlt = l15 - 4 * lg - reg;
                bool valid = tile_ok; if (kt == 0) valid = valid && (dlt < 0); if (kt == 8) valid = valid && (dlt >= 0);
                const float v = valid ? sc[kt][reg] : -1e30f; sc[kt][reg] = v; m = fmaxf(m, v); } }
        m = fmaxf(m, __shfl_xor(m, 16)); m = fmaxf(m, __shfl_xor(m, 32)); m = fmaxf(m, sink);
        float sm = 0.f;
#pragma unroll
        for (int kt = 0; kt < 9; ++kt)
#pragma unroll
            for (int reg = 0; reg < 4; ++reg) { const float p = __expf(sc[kt][reg] - m); sc[kt][reg] = p; sm += p; }
        sm += __shfl_xor(sm, 16); sm += __shfl_xor(sm, 32);
        const float invq = __builtin_amdgcn_rcpf(sm + __expf(sink - m));
        float inv[4];
#pragma unroll
        for (int reg = 0; reg < 4; ++reg) inv[reg] = __shfl(invq, 4 * lg + reg);
        bf16x8 pa[5];
#pragma unroll
        for (int ks = 0; ks < 5; ++ks) { u32x4 pw; pw.x = cvtpk(sc[2 * ks][0], sc[2 * ks][1]); pw.y = cvtpk(sc[2 * ks][2], sc[2 * ks][3]);
            if (ks < 4) { pw.z = cvtpk(sc[2 * ks + 1][0], sc[2 * ks + 1][1]); pw.w = cvtpk(sc[2 * ks + 1][2], sc[2 * ks + 1][3]); } else { pw.z = 0u; pw.w = 0u; }
            pa[ks] = __builtin_bit_cast(bf16x8, pw); }
#pragma unroll
        for (int dt = 0; dt < 4; ++dt) { f32x4 acc = (f32x4){0.f, 0.f, 0.f, 0.f};
#pragma unroll
            for (int ks = 0; ks < 5; ++ks) { const bf16_t* vp = VT + (16 * dt + l15) * 280 + 16 * w + 32 * ks + 4 * lg;
                u32x4 bw; const u32x2 lo = *(const u32x2*)vp, hi = *(const u32x2*)(vp + 16); bw.x = lo.x; bw.y = lo.y; bw.z = hi.x; bw.w = hi.y;
                acc = MFMA16(pa[ks], __builtin_bit_cast(bf16x8, bw), acc); }
#pragma unroll
            for (int reg = 0; reg < 4; ++reg) y[(tok0 + 16 * w + 4 * lg + reg) * DM + hq * 64 + 16 * dt + l15] = cvt1(acc[reg] * inv[reg]); }
    }
    LBAR();
}

#define XB_TMO      128
#define XB_XCNT(j)  (256  + 64 * (j))
#define XB_XSUB(j)  (1280 + 64 * (j))
#define XB_XGEN(j)  (2304 + 64 * (j))
#define XB_TOP      3328
#define XB_TOPGEN   3392
#define XCD_BAR_WORDS 3456
#define XB_SPIN_CAP (1u << 18)

__device__ __forceinline__ unsigned xb_ld(unsigned* p)              { return __hip_atomic_load(p, __ATOMIC_RELAXED, __HIP_MEMORY_SCOPE_AGENT); }
__device__ __forceinline__ unsigned xb_add(unsigned* p, unsigned v) { return __hip_atomic_fetch_add(p, v, __ATOMIC_RELAXED, __HIP_MEMORY_SCOPE_AGENT); }
__device__ __forceinline__ unsigned xb_xcc_id() { return (unsigned)__builtin_amdgcn_s_getreg((3 << 11) | 20) & 0xFu; }
#define XB_SPIN(cond, bar) do { unsigned _sp = 0; while (cond) { __builtin_amdgcn_s_sleep(1); \
    if ((++_sp & 255u) == 0u) { if (xb_ld(&(bar)[XB_TMO])) break; if (_sp > XB_SPIN_CAP) { atomicAdd(&(bar)[XB_TMO], 1u); break; } } } } while (0)

struct XcdBarrier {
    unsigned* bar; unsigned x;
    volatile LAS unsigned* st;
};

__device__ __forceinline__ XcdBarrier xcd_barrier_post(unsigned* bar, volatile LAS unsigned* st) {
    XcdBarrier b; b.bar = bar; b.x = xb_xcc_id(); b.st = st;
    if (threadIdx.x == 0) (void)xb_add(&bar[XB_XCNT(b.x)], 1u);
    return b;
}
__device__ __forceinline__ void xcd_barrier_complete(unsigned* bar, unsigned x, unsigned& nloc, unsigned& nx) {
    const unsigned G = gridDim.x * gridDim.y * gridDim.z;
    unsigned sum, cnt, mine, sp = 0u;
    for (;;) {
        sum = 0u; cnt = 0u; mine = 0u;
#pragma unroll
        for (unsigned j = 0; j < 16; ++j) { const unsigned c = xb_ld(&bar[XB_XCNT(j)]); sum += c; cnt += (c > 0u) ? 1u : 0u; mine = (j == x) ? c : mine; }
        if (sum == G) break;
        __builtin_amdgcn_s_sleep(1);
        if ((++sp & 255u) == 0u) { if (xb_ld(&bar[XB_TMO])) break; if (sp > XB_SPIN_CAP) { atomicAdd(&bar[XB_TMO], 1u); break; } }
    }
    nloc = mine > 0u ? mine : 1u; nx = cnt > 0u ? cnt : 1u;
}

__device__ __forceinline__ void xcd_barrier(const XcdBarrier& b) {
    asm volatile("s_waitcnt vmcnt(0)" ::: "memory");
    __syncthreads();
    if (threadIdx.x == 0) {
        unsigned* bar = b.bar;
        __builtin_amdgcn_s_waitcnt(0);
        unsigned nloc = b.st[0], nx = b.st[1];
        if (nloc == 0u) { xcd_barrier_complete(bar, b.x, nloc, nx); b.st[0] = nloc; b.st[1] = nx; }
        const unsigned old = xb_add(&bar[XB_XSUB(b.x)], 1u);
        const unsigned gen = old / nloc;
        if (old + 1u == (gen + 1u) * nloc) {
            __builtin_amdgcn_fence(__ATOMIC_RELEASE, "agent");
            asm volatile("s_waitcnt vmcnt(0)" ::: "memory");
            const unsigned og = xb_add(&bar[XB_TOP], 1u);
            const unsigned tg = og / nx;
            if (og + 1u == (tg + 1u) * nx) xb_add(&bar[XB_TOPGEN], 1u);
            else XB_SPIN(xb_ld(&bar[XB_TOPGEN]) == tg, bar);
            __builtin_amdgcn_fence(__ATOMIC_ACQUIRE, "agent");
            xb_add(&bar[XB_XGEN(b.x)], 1u);
            asm volatile("s_waitcnt vmcnt(0)" ::: "memory");
        } else {
            XB_SPIN(xb_ld(&bar[XB_XGEN(b.x)]) == gen, bar);
            __builtin_amdgcn_fence(__ATOMIC_ACQUIRE, "agent");
            asm volatile("s_waitcnt vmcnt(0)" ::: "memory");
        }
    }
    __syncthreads();
}

__device__ __forceinline__ void xcd_local_barrier(const XcdBarrier& b, unsigned* lbar) {
    asm volatile("s_waitcnt vmcnt(0)" ::: "memory");
    __syncthreads();
    if (threadIdx.x == 0) {
        __builtin_amdgcn_s_waitcnt(0);
        const unsigned nloc = b.st[0];
        const unsigned old = xb_add(&lbar[XB_XSUB(b.x)], 1u);
        const unsigned gen = old / nloc;
        if (old + 1u == (gen + 1u) * nloc) xb_add(&lbar[XB_XGEN(b.x)], 1u);
        else XB_SPIN(xb_ld(&lbar[XB_XGEN(b.x)]) == gen, lbar);
        __builtin_amdgcn_fence(__ATOMIC_ACQUIRE, "agent");
        asm volatile("s_waitcnt vmcnt(0)" ::: "memory");
    }
    __syncthreads();
}

#ifndef MK_MULTI
#define MK_MULTI 0
#endif
#define PROBE_DUP 0
__global__ void __launch_bounds__(NTHREADS, 2) trunk_fwd(Args a) {
    extern __shared__ __attribute__((aligned(16))) unsigned char lds[];
    cg::grid_group grid = cg::this_grid();
    const int G = gridDim.x, bid = blockIdx.x;
    unsigned char* ws = a.ws;
    float* rowsq = (float*)(ws + WS_ROWSQ);
    bf16_t* XB = (bf16_t*)(ws + WS_XB); bf16_t* XLO = (bf16_t*)(ws + WS_LO); bf16_t* HID = (bf16_t*)(ws + WS_HID);
    const bool grp = (G == 256); const size_t gb = (size_t)(bid & 7);
    bf16_t* Zev = grp ? (bf16_t*)(ws + WS_Z + gb * (8 * MiB)) : (bf16_t*)(ws + WS_Z);
    bf16_t* Zod = grp ? (bf16_t*)(ws + WS_Z + gb * (20 * MiB)) : (bf16_t*)(ws + WS_Z);
    bf16_t* Y = grp ? (bf16_t*)(ws + WS_Z + 24 * MiB + gb * (24 * MiB)) : (bf16_t*)(ws + WS_Y);
    const float* cosT = (const float*)(ws + WS_COS); const float* sinT = (const float*)(ws + WS_SIN);
    const int lo = a.ph_lo, hi = a.ph_hi;
#define IN(k) (lo <= (k) && (k) < hi)
    { volatile LAS unsigned* st = (volatile LAS unsigned*)((LAS unsigned char*)lds + (LDS_BYTES - 64)); if (threadIdx.x < 2) st[threadIdx.x] = 0u; }
    __syncthreads();
    XcdBarrier bar = xcd_barrier_post((unsigned*)(ws + WS_BAR), (volatile LAS unsigned*)((LAS unsigned char*)lds + (LDS_BYTES - 64)));
    unsigned* lbar = (unsigned*)(ws + WS_BAR) + XCD_BAR_WORDS;
    if (threadIdx.x == 0) { if (!grp) (void)xb_add(&lbar[0], 1u); __hip_atomic_fetch_or(&lbar[16 + (bid & 7)], 1u << bar.x, __ATOMIC_RELAXED, __HIP_MEMORY_SCOPE_AGENT); }
    bool use_local = false;
    const int last_seam = N_PHASES - 2;
#define SEAM(k) do { if (IN(k) && IN((k) + 1)) { if (use_local && (k) != 0 && (k) != last_seam) xcd_local_barrier(bar, lbar); else xcd_barrier(bar); \
        if ((k) == 0) { unsigned all_ = 0u; bool one_ = true; for (int g_ = 0; g_ < 8; ++g_) { const unsigned m_ = xb_ld(&lbar[16 + g_]); one_ = one_ && (__builtin_popcount(m_) == 1); all_ |= m_; } \
            use_local = (xb_ld(&lbar[0]) == 0u) && one_ && (__builtin_popcount(all_) == 8); } } } while (0)
    if (a.ph_hi < 0) grid.sync();
#ifndef NO_P0
    if (IN(0)) { for (int rep = 0; rep < (PROBE_DUP == 4 ? 2 : 1); ++rep) { p0_prologue(a, lds); __syncthreads(); } }
#endif
    SEAM(0);
    for (int l = 0; l < DEPTH; ++l) {
        const int pb = 1 + 7 * l; const bool even = (l & 1) == 0; const int li = l >> 1;
        bf16_t* Zl = even ? Zev : Zod;
        if (IN(pb)) for (int rep = 0; rep < (PROBE_DUP == 5 ? 2 : 1); ++rep) {
            const int N = even ? EVEN_IN : ODD_IN;
            const bf16_t* Wt = even ? (const bf16_t*)(ws + WS_WIN_EVEN) + (size_t)li * DM * EVEN_IN : (const bf16_t*)(ws + WS_WIN_ODD) + (size_t)li * DM * ODD_IN;
            pg8::Gemm g{XB, Wt, M_TOK, N, DM}; pg8::StaticOrder S; S.init(M_TOK, N, G, bid);
            pg8::EpiScaleBf16<0> E{Zl, N, rowsq + (size_t)(2 * l) * M_TOK * 16};
#if !defined(NO_GEMM) && !defined(NO_G1)
            pg8::gemm_phase<pg8::EpiScaleBf16<0>, pg8::StaticOrder, false, true>((LAS unsigned char*)lds, g, S, E);
#endif
        }
        SEAM(pb);
        if (IN(pb + 1)) {
            if (even) {
                if (G == 256) hgrn_s1(lds, (bid & 7) * 256 + (bid >> 3), 32, (bid & 7) * 256 + 256, Zl, ws, (unsigned char*)a.out, a.in[8], li);
                else hgrn_s1(lds, bid, G, 2048, Zl, ws, (unsigned char*)a.out, a.in[8], li);
                for (int it = (G == 256 ? ((bid & 7) * 32 + (bid >> 3)) : bid); it < 256; it += G)
                    rglru_item(lds, it >> 5, (it >> 2) & 7, it & 3, Zl, Y, a.in[10] + li * 2048, a.in[11] + li * 512, a.in[12] + (size_t)li * 32768, a.in[13] + li * 512,
                               a.in[14] + (size_t)li * 32768, a.in[15] + li * 512, a.in[16] + li * 512);
            } else {
                for (int it = (G == 256 ? ((bid & 7) * 128 + (bid >> 3)) : bid); it < (G == 256 ? (bid & 7) * 128 + 128 : 1024); it += (G == 256 ? 32 : G))
                    swa_item(lds, it >> 7, (it >> 2) & 31, it & 3, Zl, Y, cosT, sinT, a.in[19] + li * 64, a.in[20] + li * 64, a.in[21] + li * 16);
            }
        }
        if (even) SEAM(pb + 1);
        if (IN(pb + 2) && even) { for (int blk = (G == 256 ? ((bid & 7) * 16 + (bid >> 3)) : bid); blk < 128 && (G != 256 || bid < 128); blk += G) hgrn_s2(lds, blk, ws, (const unsigned char*)a.out, Y); }
        if (even) SEAM(pb + 2);
        if (IN(pb + 3) && even) hgrn_s3(G, bid, Zl, Y, a.in[9] + li * 512);
        SEAM(pb + 3);
        if (IN(pb + 4)) {
            const bf16_t* Wt = even ? (const bf16_t*)(ws + WS_WOUT_EVEN) + (size_t)li * DM * DM : (const bf16_t*)(ws + WS_WOUT_ODD) + (size_t)li * DM * DM;
            pg8::Gemm g{Y, Wt, M_TOK, DM, DM}; pg8::StaticOrder S; S.init(M_TOK, DM, G, bid);
            pg8::EpiResid E{XB, XLO, nullptr, rowsq + (size_t)(2 * l + 1) * M_TOK * 16, DM};
#if !defined(NO_GEMM) && !defined(NO_G2)
            pg8::gemm_phase<pg8::EpiResid, pg8::StaticOrder, false, true>((LAS unsigned char*)lds, g, S, E);
#endif
        }
        SEAM(pb + 4);
        if (IN(pb + 5)) for (int rep = 0; rep < (PROBE_DUP == 3 ? 2 : 1); ++rep) {
            pg8::Gemm g{XB, (const bf16_t*)(ws + WS_WMLP_IN) + (size_t)l * DM * DFF, M_TOK, DFF, DM}; pg8::StaticOrder S; S.init(M_TOK, DFF, G, bid);
            pg8::EpiScaleBf16<1> E{HID, DFF, rowsq + (size_t)(2 * l + 1) * M_TOK * 16};
#if !defined(NO_GEMM) && !defined(NO_G3)
            pg8::gemm_phase<pg8::EpiScaleBf16<1>, pg8::StaticOrder, false, true>((LAS unsigned char*)lds, g, S, E);
#endif
        }
        SEAM(pb + 5);
        if (IN(pb + 6)) {
            pg8::Gemm g{HID, (const bf16_t*)(ws + WS_WMLP_OUT) + (size_t)l * DM * DFF, M_TOK, DM, DFF}; pg8::StaticOrder S; S.init(M_TOK, DM, G, bid);
            pg8::EpiResid E{XB, XLO, (l + 1 < DEPTH) ? nullptr : a.out, (l + 1 < DEPTH) ? rowsq + (size_t)(2 * l + 2) * M_TOK * 16 : nullptr, DM};
#if !defined(NO_GEMM) && !defined(NO_G4)
            pg8::gemm_phase<pg8::EpiResid, pg8::StaticOrder, false, true>((LAS unsigned char*)lds, g, S, E);
#endif
        }
        SEAM(pb + 6);
    }
#undef IN
#undef SEAM
}

extern "C" void kernel_launch(void* const* d_in, const int* in_sizes, int n_in, void* d_out, int out_size, void* d_ws, size_t ws_size, hipStream_t stream) {
    static int grid = 0;
    if (grid == 0) {
        if (n_in != 22 || out_size != M_TOK * DM || ws_size < WS_END) { fprintf(stderr, "kernel_launch: unexpected shapes (n_in %d out %d ws %zu)\n", n_in, out_size, ws_size); grid = -1; return; }
        int dev = 0, cus = 0, per_cu = 0;
        (void)hipGetDevice(&dev); (void)hipDeviceGetAttribute(&cus, hipDeviceAttributeMultiprocessorCount, dev);
        if (hipFuncSetAttribute((const void*)trunk_fwd, hipFuncAttributeMaxDynamicSharedMemorySize, LDS_BYTES) != hipSuccess) { fprintf(stderr, "kernel_launch: hipFuncSetAttribute failed\n"); grid = -1; return; }
        if (hipOccupancyMaxActiveBlocksPerMultiprocessor(&per_cu, (const void*)trunk_fwd, NTHREADS, LDS_BYTES) != hipSuccess || per_cu < 1) { fprintf(stderr, "kernel_launch: occupancy query says %d\n", per_cu); per_cu = 1; }
        (void)hipGetLastError();
        grid = cus;
    }
    if (grid < 0) return;
    (void)hipMemsetAsync((char*)d_ws + WS_BAR, 0, 2 * XCD_BAR_WORDS * 4, stream);
    Args a{};
    for (int i = 0; i < 22; ++i) a.in[i] = (const float*)d_in[i];
    a.pos = (const int*)d_in[1]; a.out = (float*)d_out; a.ws = (unsigned char*)d_ws;
#if MK_MULTI
    for (int ph = 0; ph < N_PHASES; ++ph) { a.ph_lo = ph; a.ph_hi = ph + 1; hipLaunchKernelGGL(trunk_fwd, dim3(grid), dim3(NTHREADS), LDS_BYTES, stream, a); }
#else
    a.ph_lo = 0; a.ph_hi = N_PHASES;
    void* args[] = {&a};
    hipError_t e = hipLaunchCooperativeKernel((const void*)trunk_fwd, dim3(grid), dim3(NTHREADS), args, LDS_BYTES, stream);
    if (e != hipSuccess) fprintf(stderr, "cooperative launch failed: %s (grid %d)\n", hipGetErrorString(e), grid);
#endif
}
```

```cpp
#include <hip/hip_runtime.h>
#include <hip/hip_cooperative_groups.h>
#include <cstdio>
#include <cstdint>
namespace cg = cooperative_groups;
namespace pg8 {
#define PG8_LAS __attribute__((address_space(3)))
typedef unsigned short bf16_t;
typedef short bf16x8 __attribute__((ext_vector_type(8)));
typedef float f32x4 __attribute__((ext_vector_type(4)));
typedef unsigned u32x4 __attribute__((ext_vector_type(4)));
constexpr int BM = 256, BK = 64, HALF = 128, HTB = HALF * BK * 2  , STAGE_BYTES = 8 * HTB, NXCD = 8, WGM = 4;

__host__ __device__ __forceinline__ int lds_byte(int r, int c) { const int st = (r >> 4) * 2 + (c >> 5), rr = r & 15, cc = c & 31, ob = rr * 64 + cc * 2; return st * 1024 + (ob ^ (((ob >> 9) & 1) << 5)); }
__host__ __device__ __forceinline__ void stage_rc(int b, int& R, int& C) { const int st = b / 1024, sb = b % 1024, swz = sb ^ (((sb >> 9) & 1) << 5); R = (st >> 1) * 16 + swz / 64; C = (st & 1) * 32 + (swz % 64) / 2; }
__host__ __device__ __forceinline__ int perm32(int rho) { const int n = rho >> 4, i = rho & 15; return 8 * (i >> 2) + 4 * n + (i & 3); }

struct Unit { int pm, pn; };
struct Gemm { const bf16_t* A; const bf16_t* Bt; int M, N, K; };

struct StaticOrder {
    int nM, nN, nwg, G, c;
    __host__ __device__ void init(int M, int N, int G_, int c_) { nM = M / BM; nN = N / BM; nwg = nM * nN; G = G_; c = c_; }
    __host__ __device__ bool next(int i, Unit& u) const {
        const long L = (long)i * G + c; if (L >= nwg) return false;
        int wgid = (int)L; { const int q = nwg / NXCD, r = nwg % NXCD, xcd = wgid % NXCD, off = wgid / NXCD; wgid = (xcd < r ? xcd * (q + 1) : r * (q + 1) + (xcd - r) * q) + off; }
        const int nig = WGM * nN, gid = wgid / nig, fm = gid * WGM, gsz = (nM - fm) < WGM ? (nM - fm) : WGM;
        u.pm = fm + ((wgid % nig) % gsz); u.pn = (wgid % nig) / gsz; return true;
    }
    __device__ __forceinline__ void a_ready(const Unit&) const {}
    __device__ __forceinline__ void done(const Unit&) const {}
};
__device__ __forceinline__ unsigned cvt_pk_bf16(float lo, float hi) { unsigned r; asm volatile("v_cvt_pk_bf16_f32 %0, %1, %2" : "=v"(r) : "v"(lo), "v"(hi)); return r; }
template <int ACT> struct EpiScaleBf16 {
    static constexpr bool PERM = true, AFTER_DRAIN = false;
    bf16_t* O; int ldc; const float* rowsq;
    __device__ __forceinline__ void operator()(const f32x4 (&acc)[2][2][4][2], const Unit& u, int wr, int wc, int fr, int fq) const {
        const int row0 = u.pm * BM + wr * 64 + fr; const int col0 = u.pn * BM + wc * 32 + 8 * fq;
        f32x4 pr[2][4];
#pragma unroll
        for (int ai = 0; ai < 2; ++ai)
#pragma unroll
            for (int m = 0; m < 4; ++m) pr[ai][m] = *(const f32x4*)(rowsq + (size_t)(row0 + ai * HALF + m * 16) * 16 + 4 * fq);
        float rsv[2][4];
#pragma unroll
        for (int ai = 0; ai < 2; ++ai)
#pragma unroll
            for (int m = 0; m < 4; ++m) { float t = (pr[ai][m][0] + pr[ai][m][1]) + (pr[ai][m][2] + pr[ai][m][3]); t += __shfl_xor(t, 16); t += __shfl_xor(t, 32); rsv[ai][m] = rsqrtf(t * (1.0f / 1024.0f) + 1e-6f); }
#pragma unroll
        for (int ai = 0; ai < 2; ++ai)
#pragma unroll
            for (int m = 0; m < 4; ++m) { const int row = row0 + ai * HALF + m * 16; const float s = rsv[ai][m];
                bf16_t* rowp = O + (size_t)row * ldc + col0;
#pragma unroll
                for (int bj = 0; bj < 2; ++bj) { f32x4 v0 = acc[ai][bj][m][0] * s, v1 = acc[ai][bj][m][1] * s;
                    if (ACT == 1) {
#pragma unroll
                        for (int q = 0; q < 4; ++q) { const float a = fmaxf(v0[q], 0.f), b = fmaxf(v1[q], 0.f); v0[q] = a * a; v1[q] = b * b; } }
                    u32x4 w; w.x = cvt_pk_bf16(v0[0], v0[1]); w.y = cvt_pk_bf16(v0[2], v0[3]); w.z = cvt_pk_bf16(v1[0], v1[1]); w.w = cvt_pk_bf16(v1[2], v1[3]);
                    if (ACT == 1) __builtin_nontemporal_store(w, (u32x4*)(rowp + bj * HALF)); else *(u32x4*)(rowp + bj * HALF) = w; } }
    }
};
struct EpiResid {
    static constexpr bool PERM = true, AFTER_DRAIN = false;
    bf16_t* hi; bf16_t* lo; float* fin; float* rowsq_next; int ldc;
    __device__ __forceinline__ void operator()(const f32x4 (&acc)[2][2][4][2], const Unit& u, int wr, int wc, int fr, int fq) const {
        const int row0 = u.pm * BM + wr * 64 + fr; const int col0 = u.pn * BM + wc * 32 + 8 * fq;
        u32x4 ph[8][2], pl[8][2];
#define ER_GLD(dst, p, OFF) asm volatile("global_load_dwordx4 %0, %1, off offset:" #OFF : "=v"(dst) : "v"(p) : "memory")
#define ER_LOAD(g) do { const size_t off_ = (size_t)(row0 + ((g) >> 2) * HALF + ((g) & 3) * 16) * ldc + col0; const bf16_t* hp_ = hi + off_; const bf16_t* lp_ = lo + off_; \
            ER_GLD(ph[g][0], hp_, 0); ER_GLD(pl[g][0], lp_, 0); ER_GLD(ph[g][1], hp_, 256); ER_GLD(pl[g][1], lp_, 256); } while (0)
#define ER_WAIT(N, g) asm volatile("s_waitcnt vmcnt(" #N ")" : "+v"(ph[g][0]), "+v"(pl[g][0]), "+v"(ph[g][1]), "+v"(pl[g][1]) : : "memory")
#define ER_PROC(g) do { const int ai_ = (g) >> 2, m_ = (g) & 3; const int row_ = row0 + ai_ * HALF + m_ * 16; const size_t off_ = (size_t)row_ * ldc + col0; float ss_ = 0.f; \
            _Pragma("unroll") for (int bj = 0; bj < 2; ++bj) { unsigned ob_[8]; \
                _Pragma("unroll") for (int q = 0; q < 4; ++q) { const unsigned H = ph[g][bj][q], L = pl[g][bj][q]; \
                    const float x0 = __uint_as_float((H << 16) | (L & 0xffffu)), x1 = __uint_as_float((H & 0xffff0000u) | (L >> 16)); \
                    const float a0 = (q < 2) ? acc[ai_][bj][m_][0][2 * q] : acc[ai_][bj][m_][1][2 * q - 4], a1 = (q < 2) ? acc[ai_][bj][m_][0][2 * q + 1] : acc[ai_][bj][m_][1][2 * q - 3]; \
                    ob_[2 * q] = __float_as_uint(x0 + a0); ob_[2 * q + 1] = __float_as_uint(x1 + a1); } \
                _Pragma("unroll") for (int k = 0; k < 8; ++k) { const float t = __uint_as_float(ob_[k] & 0xffff0000u); ss_ += t * t; } \
                if (fin != nullptr) { f32x4 o0, o1; o0[0] = __uint_as_float(ob_[0]); o0[1] = __uint_as_float(ob_[1]); o0[2] = __uint_as_float(ob_[2]); o0[3] = __uint_as_float(ob_[3]); \
                    o1[0] = __uint_as_float(ob_[4]); o1[1] = __uint_as_float(ob_[5]); o1[2] = __uint_as_float(ob_[6]); o1[3] = __uint_as_float(ob_[7]); \
                    *(f32x4*)(fin + off_ + bj * HALF) = o0; *(f32x4*)(fin + off_ + bj * HALF + 4) = o1; } \
                else { u32x4 wh, wl; \
                    wh.x = (ob_[0] >> 16) | (ob_[1] & 0xffff0000u); wh.y = (ob_[2] >> 16) | (ob_[3] & 0xffff0000u); wh.z = (ob_[4] >> 16) | (ob_[5] & 0xffff0000u); wh.w = (ob_[6] >> 16) | (ob_[7] & 0xffff0000u); \
                    wl.x = (ob_[0] & 0xffffu) | (ob_[1] << 16); wl.y = (ob_[2] & 0xffffu) | (ob_[3] << 16); wl.z = (ob_[4] & 0xffffu) | (ob_[5] << 16); wl.w = (ob_[6] & 0xffffu) | (ob_[7] << 16); \
                    *(u32x4*)(hi + off_ + bj * HALF) = wh; *(u32x4*)(lo + off_ + bj * HALF) = wl; } } \
            ss_ += __shfl_xor(ss_, 16); ss_ += __shfl_xor(ss_, 32); \
            if (rowsq_next != nullptr && fq == 0) rowsq_next[(size_t)row_ * 16 + u.pn * 4 + wc] = ss_; } while (0)
        static_assert(HALF * 2 == 256, "bj offset in the asm loads");
        ER_LOAD(0); ER_LOAD(1); ER_LOAD(2);
        ER_WAIT(8, 0); ER_PROC(0); ER_LOAD(3); ER_WAIT(8, 1); ER_PROC(1); ER_LOAD(4); ER_WAIT(8, 2); ER_PROC(2); ER_LOAD(5); ER_WAIT(8, 3); ER_PROC(3); ER_LOAD(6);
        ER_WAIT(8, 4); ER_PROC(4); ER_LOAD(7); ER_WAIT(8, 5); ER_PROC(5); ER_WAIT(4, 6); ER_PROC(6); ER_WAIT(0, 7); ER_PROC(7);
#undef ER_GLD
#undef ER_WAIT
#undef ER_LOAD
#undef ER_PROC
    }
};
template <class Epi, class Sched, bool ALIGN_EPI = false, bool SP2 = false>
__device__ __forceinline__ void gemm_phase(PG8_LAS unsigned char* lds, const Gemm g, const Sched& S, const Epi& E) {
    int tid_ = threadIdx.x; asm volatile("" : "+v"(tid_));
    const int tid = tid_, wid = __builtin_amdgcn_readfirstlane(tid >> 6), lane = tid & 63, wr = wid >> 2, wc = wid & 3, fr = lane & 15, fq = lane >> 4;
    const int K = g.K, nt = K / BK;
    unsigned voffA[2], voffB[2];
#pragma unroll
    for (int i = 0; i < 2; ++i) { int R, C; stage_rc(tid * 16 + i * 8192, R, C); const int Rb = Epi::PERM ? ((R & ~31) + perm32(R & 31)) : R;
        voffA[i] = (unsigned)(R * K + C) * 2u; voffB[i] = (unsigned)(Rb * K + C) * 2u; }
    const size_t kstep = (size_t)(BK * 2);
    const size_t hstep = (size_t)HALF * K * 2;
    const size_t tstep = 2 * hstep;
    const unsigned ldsw = (unsigned)wid * 1024u;
    const int aoff = lds_byte(wr * 64 + fr, fq * 8), boff = lds_byte(wc * 32 + fr, fq * 8);
#define PG8_SA(b, h) (((b) * 2 + (h)) * HTB)
#define PG8_SB(b, h) ((4 + (b) * 2 + (h)) * HTB)
#define PG8_STAGE(bufoff, gbase, voff) do { _Pragma("unroll") for (int _i = 0; _i < 2; ++_i) \
        __builtin_amdgcn_global_load_lds((const unsigned*)((const char*)(gbase) + (voff)[_i]), (PG8_LAS unsigned*)(lds + (bufoff) + ldsw + _i * 8192), 16, 0, 0); } while (0)
#define PG8_LDA(dst, b, h) do { _Pragma("unroll") for (int m = 0; m < 4; ++m) _Pragma("unroll") for (int k = 0; k < 2; ++k) dst[m][k] = *(const PG8_LAS bf16x8*)(lds + PG8_SA(b, h) + aoff + m * 2048 + k * 1024); } while (0)
#define PG8_LDB(dst, b, h) do { _Pragma("unroll") for (int n = 0; n < 2; ++n) _Pragma("unroll") for (int k = 0; k < 2; ++k) dst[n][k] = *(const PG8_LAS bf16x8*)(lds + PG8_SB(b, h) + boff + n * 2048 + k * 1024); } while (0)
#define PG8_MMA(ai, bj, At, Bt) do { __builtin_amdgcn_s_setprio(1); _Pragma("unroll") for (int m = 0; m < 4; ++m) _Pragma("unroll") for (int n = 0; n < 2; ++n) _Pragma("unroll") for (int k = 0; k < 2; ++k) \
        acc[ai][bj][m][n] = __builtin_amdgcn_mfma_f32_16x16x32_bf16(Bt[n][k], At[m][k], acc[ai][bj][m][n], 0, 0, 0); __builtin_amdgcn_s_setprio(0); } while (0)
#define PG8_WAIT_V(n) asm volatile("s_waitcnt vmcnt(" #n ")" ::: "memory")
#define PG8_WAIT_L(n) asm volatile("s_waitcnt lgkmcnt(" #n ")" ::: "memory")
#define PG8_BAR __builtin_amdgcn_s_barrier()
#define PG8_SCHED __builtin_amdgcn_sched_barrier(0)
    Unit cur, nxt; int ui = 0;
    if (!S.next(0, cur)) return;
    f32x4 acc[2][2][4][2];
#pragma unroll
    for (int a = 0; a < 2; ++a)
#pragma unroll
        for (int b = 0; b < 2; ++b)
#pragma unroll
            for (int m = 0; m < 4; ++m)
#pragma unroll
                for (int n = 0; n < 2; ++n) acc[a][b][m][n] = (f32x4){0.f, 0.f, 0.f, 0.f};
    bf16x8 At[4][2], B0[2][2], B1[2][2];
    const char* cA = (const char*)g.A + (size_t)cur.pm * tstep; const char* cB = (const char*)g.Bt + (size_t)cur.pn * tstep;
    S.a_ready(cur);
    if constexpr (SP2) {
        PG8_STAGE(PG8_SB(0, 0), cB, voffB); PG8_STAGE(PG8_SB(0, 1), cB + hstep, voffB); PG8_STAGE(PG8_SA(0, 0), cA, voffA); PG8_STAGE(PG8_SA(0, 1), cA + hstep, voffA);
        if (wr == 1) PG8_BAR;
        PG8_WAIT_V(2); PG8_BAR;
        PG8_STAGE(PG8_SB(1, 0), cB + kstep, voffB); PG8_STAGE(PG8_SA(1, 0), cA + kstep, voffA); PG8_STAGE(PG8_SB(1, 1), cB + hstep + kstep, voffB);
        PG8_WAIT_V(6); PG8_BAR;
    } else {
        PG8_STAGE(PG8_SB(0, 0), cB, voffB); PG8_STAGE(PG8_SA(0, 0), cA, voffA); PG8_STAGE(PG8_SB(0, 1), cB + hstep, voffB); PG8_STAGE(PG8_SA(0, 1), cA + hstep, voffA);
        if (wr == 1) PG8_BAR;
        PG8_WAIT_V(4); PG8_BAR;
        PG8_STAGE(PG8_SB(1, 0), cB + kstep, voffB); PG8_STAGE(PG8_SA(1, 0), cA + kstep, voffA); PG8_STAGE(PG8_SB(1, 1), cB + hstep + kstep, voffB);
        PG8_WAIT_V(6); PG8_BAR;
    }
    for (;;) {
        const bool has_next = S.next(ui + 1, nxt);
        const char* nA = has_next ? (const char*)g.A + (size_t)nxt.pm * tstep : cA; const char* nB = has_next ? (const char*)g.Bt + (size_t)nxt.pn * tstep : cB;
        for (int t = 0; t < nt; t += 2) {
            const bool last = (t == nt - 2);
            const char* a1 = cA + (size_t)(t + 1) * kstep;
            const char* a2 = last ? nA : cA + (size_t)(t + 2) * kstep; const char* b2 = last ? nB : cB + (size_t)(t + 2) * kstep;
            const char* a3 = a2 + kstep; const char* b3 = b2 + kstep;
            if (last && has_next) S.a_ready(nxt);
            if constexpr (SP2) {
            PG8_LDB(B0, 0, 0); PG8_LDB(B1, 0, 1); PG8_SCHED; PG8_LDA(At, 0, 0); PG8_STAGE(PG8_SA(1, 1), a1 + hstep, voffA);
            PG8_WAIT_V(8); PG8_WAIT_L(0); PG8_BAR; PG8_MMA(0, 0, At, B0); PG8_MMA(0, 1, At, B1); PG8_BAR; PG8_SCHED;
            PG8_LDA(At, 0, 1); PG8_STAGE(PG8_SB(0, 0), b2, voffB); PG8_STAGE(PG8_SB(0, 1), b2 + hstep, voffB); PG8_STAGE(PG8_SA(0, 0), a2, voffA);
            PG8_WAIT_V(8); PG8_WAIT_L(0); PG8_BAR; PG8_MMA(1, 0, At, B0); PG8_MMA(1, 1, At, B1); PG8_BAR; PG8_SCHED;
            PG8_LDB(B0, 1, 0); PG8_LDB(B1, 1, 1); PG8_SCHED; PG8_LDA(At, 1, 0); PG8_STAGE(PG8_SA(0, 1), a2 + hstep, voffA);
            PG8_WAIT_V(8); PG8_WAIT_L(0); PG8_BAR; PG8_MMA(0, 0, At, B0); PG8_MMA(0, 1, At, B1); PG8_BAR; PG8_SCHED;
            PG8_LDA(At, 1, 1); PG8_STAGE(PG8_SB(1, 0), b3, voffB); PG8_STAGE(PG8_SB(1, 1), b3 + hstep, voffB); PG8_STAGE(PG8_SA(1, 0), a3, voffA);
            PG8_WAIT_V(8); PG8_WAIT_L(0); PG8_BAR; PG8_MMA(1, 0, At, B0); PG8_MMA(1, 1, At, B1); PG8_BAR; PG8_SCHED;
            } else {
            PG8_LDB(B0, 0, 0); PG8_SCHED; PG8_LDA(At, 0, 0); PG8_STAGE(PG8_SA(1, 1), a1 + hstep, voffA);
            PG8_WAIT_L(8); PG8_BAR; PG8_WAIT_L(0); PG8_MMA(0, 0, At, B0); PG8_BAR; PG8_SCHED;
            PG8_LDB(B1, 0, 1); PG8_STAGE(PG8_SB(0, 0), b2, voffB);
            PG8_BAR; PG8_WAIT_L(0); PG8_MMA(0, 1, At, B1); PG8_BAR;
            PG8_LDA(At, 0, 1); PG8_STAGE(PG8_SA(0, 0), a2, voffA);
            PG8_BAR; PG8_WAIT_L(0); PG8_MMA(1, 0, At, B0); PG8_BAR; PG8_SCHED;
            PG8_STAGE(PG8_SB(0, 1), b2 + hstep, voffB);
            PG8_WAIT_V(6); PG8_BAR; PG8_MMA(1, 1, At, B1); PG8_BAR;
            PG8_LDB(B0, 1, 0); PG8_SCHED; PG8_LDA(At, 1, 0); PG8_STAGE(PG8_SA(0, 1), a2 + hstep, voffA);
            PG8_WAIT_L(8); PG8_BAR; PG8_WAIT_L(0); PG8_MMA(0, 0, At, B0); PG8_BAR; PG8_SCHED;
            PG8_LDB(B1, 1, 1); PG8_STAGE(PG8_SB(1, 0), b3, voffB);
            PG8_BAR; PG8_WAIT_L(0); PG8_MMA(0, 1, At, B1); PG8_BAR;
            PG8_LDA(At, 1, 1); PG8_STAGE(PG8_SA(1, 0), a3, voffA);
            PG8_BAR; PG8_WAIT_L(0); PG8_MMA(1, 0, At, B0); PG8_BAR; PG8_SCHED;
            PG8_STAGE(PG8_SB(1, 1), b3 + hstep, voffB);
            PG8_WAIT_V(6); PG8_BAR; PG8_MMA(1, 1, At, B1); PG8_BAR;
            }
        }
        if constexpr (ALIGN_EPI) { if (wr == 0) PG8_BAR; }
        if constexpr (!Epi::AFTER_DRAIN) { E(acc, cur, wr, wc, fr, fq); S.done(cur); }
        if (!has_next) break;
#pragma unroll
        for (int a = 0; a < 2; ++a)
#pragma unroll
            for (int b = 0; b < 2; ++b)
#pragma unroll
                for (int m = 0; m < 4; ++m)
#pragma unroll
                    for (int n = 0; n < 2; ++n) acc[a][b][m][n] = (f32x4){0.f, 0.f, 0.f, 0.f};
        cur = nxt; cA = nA; cB = nB; ++ui;
        if constexpr (ALIGN_EPI) { if (wr == 1) PG8_BAR; }
    }
    PG8_WAIT_V(0);
    if constexpr (!ALIGN_EPI) { if (wr == 0) PG8_BAR; }
    PG8_BAR;
    if constexpr (Epi::AFTER_DRAIN) { E.fused(acc, cur, wr, wc, fr, fq, lds, wid, lane); S.done(cur); }
#undef PG8_SA
#undef PG8_SB
#undef PG8_STAGE
#undef PG8_LDA
#undef PG8_LDB
#undef PG8_MMA
#undef PG8_WAIT_V
#undef PG8_WAIT_L
#undef PG8_BAR
#undef PG8_SCHED
}
}

constexpr int BATCH = 8, SEQ = 4096, DM = 1024, DEPTH = 4, DFF = 4096;
constexpr int M_TOK = BATCH * SEQ;
constexpr int EVEN_IN = 3072, ODD_IN = 1536;
constexpr int NWAVES = 8, NTHREADS = 512;
constexpr int LDS_BYTES = 157696;
constexpr int N_PHASES = 1 + 7 * DEPTH;

constexpr size_t MiB = 1u << 20;
constexpr size_t WS_ROWSQ = 420 * MiB;
constexpr size_t WS_BAR = 1 * MiB;
constexpr size_t WS_WMLP_IN = 2 * MiB;
constexpr size_t WS_WMLP_OUT = 34 * MiB;
constexpr size_t WS_WIN_EVEN = 66 * MiB;
constexpr size_t WS_WOUT_EVEN = 78 * MiB;
constexpr size_t WS_WIN_ODD = 82 * MiB;
constexpr size_t WS_WOUT_ODD = 88 * MiB;
constexpr size_t WS_COS = 92 * MiB, WS_SIN = 96 * MiB;
constexpr size_t WS_XB = 100 * MiB;
constexpr size_t WS_Z = 164 * MiB;
constexpr size_t WS_Y = 356 * MiB;
constexpr size_t WS_HID = 164 * MiB;
constexpr size_t WS_LO = 436 * MiB;
constexpr size_t OUT_HU = 0, OUT_HQT = 64 * MiB, OUT_HOI = 96 * MiB;
constexpr size_t WS_HDL = 500 * MiB;
constexpr size_t WS_END = 501 * MiB;

typedef unsigned short bf16_t;
typedef short bf16x8 __attribute__((ext_vector_type(8)));
typedef float f32x4 __attribute__((ext_vector_type(4)));
typedef unsigned u32x4 __attribute__((ext_vector_type(4)));
typedef unsigned u32x2 __attribute__((ext_vector_type(2)));
#define LAS __attribute__((address_space(3)))
#define MFMA16(a, b, c) __builtin_amdgcn_mfma_f32_16x16x32_bf16((a), (b), (c), 0, 0, 0)

__device__ __forceinline__ float bf2f(unsigned u) { return __uint_as_float(u << 16); }
__device__ __forceinline__ float bflo(unsigned u) { return __uint_as_float(u << 16); }
__device__ __forceinline__ float bfhi(unsigned u) { return __uint_as_float(u & 0xffff0000u); }
__device__ __forceinline__ unsigned f2bf(float f) { unsigned u = __float_as_uint(f); return (u + 0x7fffu + ((u >> 16) & 1u)) >> 16; }
__device__ __forceinline__ unsigned pk2(float lo, float hi) { return f2bf(lo) | (f2bf(hi) << 16); }
__device__ __forceinline__ float wave_sum(float v) {
#pragma unroll
    for (int o = 1; o < 64; o <<= 1) v += __shfl_xor(v, o);
    return v;
}
__device__ __forceinline__ float red16_sum(float v) { v += __shfl_xor(v, 1); v += __shfl_xor(v, 2); v += __shfl_xor(v, 4); v += __shfl_xor(v, 8); return v; }
__device__ __forceinline__ float red16_max(float v) { v = fmaxf(v, __shfl_xor(v, 1)); v = fmaxf(v, __shfl_xor(v, 2)); v = fmaxf(v, __shfl_xor(v, 4)); v = fmaxf(v, __shfl_xor(v, 8)); return v; }
__device__ __forceinline__ bf16x8 ldfrag(const bf16_t* p) { return *(const bf16x8*)p; }

struct Args {
    const float* in[22]; const int* pos; float* out; unsigned char* ws; int ph_lo, ph_hi;
};

__device__ __forceinline__ void p0_transpose_item(const float* W, int K, int N, bf16_t* WT, const float* gain, float* scr, int item, int lane) {
    const int nblk = N / 64, kb = item / nblk, nb = item % nblk, k0 = 64 * kb, n0 = 64 * nb;
    const int c4 = (lane & 15) * 4;
#pragma unroll 8
    for (int i = 0; i < 16; ++i) { const int kk = 4 * i + (lane >> 4); const float g = gain ? gain[k0 + kk] : 1.0f;
        const f32x4 v = *(const f32x4*)(W + (size_t)(k0 + kk) * N + n0 + c4);
        float* d = scr + kk * 65 + c4; d[0] = v[0] * g; d[1] = v[1] * g; d[2] = v[2] * g; d[3] = v[3] * g; }
    asm volatile("s_waitcnt lgkmcnt(0)" ::: "memory");
    const int c = lane & 7;
#pragma unroll
    for (int j = 0; j < 8; ++j) { const int n = (lane >> 3) + 8 * j; const float* s = scr + (8 * c) * 65 + n;
        u32x4 o; o.x = pk2(s[0 * 65], s[1 * 65]); o.y = pk2(s[2 * 65], s[3 * 65]); o.z = pk2(s[4 * 65], s[5 * 65]); o.w = pk2(s[6 * 65], s[7 * 65]);
        *(u32x4*)(WT + (size_t)(n0 + n) * K + k0 + 8 * c) = o; }
    asm volatile("s_waitcnt lgkmcnt(0)" ::: "memory");
}

__device__ __forceinline__ void p0_prologue(const Args& a, unsigned char* lds) {
    int tid_ = threadIdx.x; asm volatile("" : "+v"(tid_));
    const int tid = tid_, lane = tid & 63, wave = tid >> 6;
    const int G = gridDim.x, bid = blockIdx.x;
    const int gw = bid * NWAVES + wave, NGW = G * NWAVES;
    const int gt = bid * NTHREADS + tid, NGT = G * NTHREADS;
    unsigned char* ws = a.ws;
    float* scr = (float*)(lds + wave * 17408);
    const float* norm_mix = a.in[2]; const float* norm_mlp = a.in[3];
    constexpr int NITEMS = 4 * 2048 + 2 * 1024 + 2 * 640;
    for (int it0 = gw; it0 < NITEMS; it0 += NGW) {
        int it = it0;
        if (it < 8192) { const int l = it >> 11, r = it & 2047;
            if (r < 1024) p0_transpose_item(a.in[4] + (size_t)l * DM * DFF, DM, DFF, (bf16_t*)(ws + WS_WMLP_IN) + (size_t)l * DM * DFF, norm_mlp + l * DM, scr, r, lane);
            else p0_transpose_item(a.in[5] + (size_t)l * DM * DFF, DFF, DM, (bf16_t*)(ws + WS_WMLP_OUT) + (size_t)l * DM * DFF, nullptr, scr, r - 1024, lane);
            continue; }
        it -= 8192;
        if (it < 2048) { const int e = it >> 10, r = it & 1023;
            if (r < 768) p0_transpose_item(a.in[6] + (size_t)e * DM * EVEN_IN, DM, EVEN_IN, (bf16_t*)(ws + WS_WIN_EVEN) + (size_t)e * DM * EVEN_IN, norm_mix + (2 * e) * DM, scr, r, lane);
            else p0_transpose_item(a.in[7] + (size_t)e * DM * DM, DM, DM, (bf16_t*)(ws + WS_WOUT_EVEN) + (size_t)e * DM * DM, nullptr, scr, r - 768, lane);
            continue; }
        it -= 2048;
        { const int o = it / 640, r = it % 640;
            if (r < 384) p0_transpose_item(a.in[17] + (size_t)o * DM * ODD_IN, DM, ODD_IN, (bf16_t*)(ws + WS_WIN_ODD) + (size_t)o * DM * ODD_IN, norm_mix + (2 * o + 1) * DM, scr, r, lane);
            else p0_transpose_item(a.in[18] + (size_t)o * DM * DM, DM, DM, (bf16_t*)(ws + WS_WOUT_ODD) + (size_t)o * DM * DM, nullptr, scr, r - 384, lane); }
    }
    { const float* x = a.in[0]; bf16_t* xb = (bf16_t*)(ws + WS_XB); bf16_t* xl = (bf16_t*)(ws + WS_LO); float* rq0 = (float*)(ws + WS_ROWSQ);
      const bool xa = (G == 256);
      for (int m = xa ? ((bid & 7) * 4096 + 2 * ((bid >> 3) * 8 + wave)) : 2 * gw; m < (xa ? (bid & 7) * 4096 + 4096 : M_TOK); m += (xa ? 512 : 2 * NGW)) {
          const u32x4* xr = (const u32x4*)(x + (size_t)m * DM) + lane; u32x2* oh = (u32x2*)(xb + (size_t)m * DM) + lane; u32x2* ol = (u32x2*)(xl + (size_t)m * DM) + lane;
          u32x4 v[8];
#pragma unroll
          for (int j = 0; j < 8; ++j) v[j] = xr[64 * j];
          float s0 = 0.f, s1 = 0.f;
#pragma unroll
          for (int j = 0; j < 8; ++j) { const float t0 = __uint_as_float(v[j][0] & 0xffff0000u), t1 = __uint_as_float(v[j][1] & 0xffff0000u), t2 = __uint_as_float(v[j][2] & 0xffff0000u), t3 = __uint_as_float(v[j][3] & 0xffff0000u);
              const float q = (t0 * t0 + t1 * t1) + (t2 * t2 + t3 * t3); if (j < 4) s0 += q; else s1 += q;
              u32x2 wh, wl; wh.x = (v[j][0] >> 16) | (v[j][1] & 0xffff0000u); wh.y = (v[j][2] >> 16) | (v[j][3] & 0xffff0000u);
              wl.x = (v[j][0] & 0xffffu) | (v[j][1] << 16); wl.y = (v[j][2] & 0xffffu) | (v[j][3] << 16); oh[64 * j] = wh; ol[64 * j] = wl; }
          s0 = wave_sum(s0); s1 = wave_sum(s1);
          if (lane < 32) rq0[(size_t)m * 16 + lane] = (lane == 0) ? s0 : ((lane == 16) ? s1 : 0.f); } }
    { float* cs = (float*)(ws + WS_COS); float* sn = (float*)(ws + WS_SIN);
      for (int i = gt; i < M_TOK * 32; i += NGT) { const int tok = i >> 5, j = i & 31;
          const float invf = exp2f(-(float)j * (13.287712379549449f / 32.0f));
          const float ang = (float)a.pos[tok] * invf;
          double rev = (double)ang * 0.15915494309189535; rev -= rint(rev);
          const float fr = (float)rev;
          sn[i] = __builtin_amdgcn_sinf(fr); cs[i] = __builtin_amdgcn_cosf(fr); } }
}

#define LBAR() asm volatile("s_waitcnt lgkmcnt(0)\n\ts_barrier" ::: "memory")
typedef float f32x2_t __attribute__((ext_vector_type(2))); typedef __bf16 bf16x2_t __attribute__((ext_vector_type(2)));
__device__ __forceinline__ unsigned cvtpk(float lo, float hi) { f32x2_t v = {lo, hi}; bf16x2_t b = __builtin_convertvector(v, bf16x2_t); return __builtin_bit_cast(unsigned, b); }
__device__ __forceinline__ bf16_t cvt1(float v) { return (bf16_t)(cvtpk(v, 0.f) & 0xffffu); }
__device__ __forceinline__ void hgrn_s1(unsigned char* lds, int it0, int step, int iend, const bf16_t* z, unsigned char* ws, unsigned char* hb, const float* lb_logits, int e_layer) {
    int tid_ = threadIdx.x; asm volatile("" : "+v"(tid_));
    const int tid = tid_, lane = tid & 63, w = tid >> 6, l15 = lane & 15, lg = lane >> 4;
    bf16_t* Qm = (bf16_t*)(lds + 0);
    bf16_t* Km = (bf16_t*)(lds + 17408);
    bf16_t* Qt = (bf16_t*)(lds + 34816);
    bf16_t* KdT = (bf16_t*)(lds + 52224);
    bf16_t* vT = (bf16_t*)(lds + 70656);
    bf16_t* P = (bf16_t*)(lds + 123904);
    float* segtot = (float*)(lds + 133120);
    bf16_t* QT = (bf16_t*)(hb + OUT_HQT); bf16_t* HU = (bf16_t*)(hb + OUT_HU); bf16_t* OI = (bf16_t*)(hb + OUT_HOI); float* DL = (float*)(ws + WS_HDL);
    const int tt = w >> 1, eh = w & 1;
    u32x4 rq[2], rf[2], rv[2];
    int it = it0;
    if (it < iend) { const size_t row0 = (size_t)(it >> 8) * SEQ + 64 * (it & 63); const int h = (it >> 6) & 3;
#pragma unroll
        for (int i = 0; i < 2; ++i) { const int idx = tid + 512 * i, r = idx >> 4, ch = idx & 15; const bf16_t* p = z + (row0 + r) * EVEN_IN + h * 128 + ch * 8;
            rq[i] = *(const u32x4*)p; rf[i] = *(const u32x4*)(p + 512);
            const int rv_r = idx & 63, rv_ch = idx >> 6; rv[i] = *(const u32x4*)(z + (row0 + rv_r) * EVEN_IN + 1024 + h * 128 + rv_ch * 8); } }
    for (; it < iend; it += step) {
        const int h = (it >> 6) & 3;
        const int c0 = h * 128 + 2 * lane;
        float lb0 = 0.f, lb1 = 0.f;
        if (e_layer == 1) { lb0 = 1.0f / (1.0f + __expf(lb_logits[c0] - lb_logits[512 + c0])); lb1 = 1.0f / (1.0f + __expf(lb_logits[c0 + 1] - lb_logits[512 + c0 + 1])); }
        const float om0 = 1.0f - lb0, om1 = 1.0f - lb1;
#pragma unroll
        for (int i = 0; i < 2; ++i) { const int idx = tid + 512 * i, r = idx >> 4, ch = idx & 15;
            *(u32x4*)(Qm + r * 136 + ch * 8) = rq[i]; *(u32x4*)(Km + r * 136 + ch * 8) = rf[i];
            const int vr = idx & 63, vch = idx >> 6; const u32x4 v = rv[i];
            vT[(vch * 8 + 0) * 72 + vr] = (bf16_t)(v.x & 0xffffu); vT[(vch * 8 + 1) * 72 + vr] = (bf16_t)(v.x >> 16);
            vT[(vch * 8 + 2) * 72 + vr] = (bf16_t)(v.y & 0xffffu); vT[(vch * 8 + 3) * 72 + vr] = (bf16_t)(v.y >> 16);
            vT[(vch * 8 + 4) * 72 + vr] = (bf16_t)(v.z & 0xffffu); vT[(vch * 8 + 5) * 72 + vr] = (bf16_t)(v.z >> 16);
            vT[(vch * 8 + 6) * 72 + vr] = (bf16_t)(v.w & 0xffffu); vT[(vch * 8 + 7) * 72 + vr] = (bf16_t)(v.w >> 16); }
        if (it + step < iend) { const int nx = it + step; const size_t row0 = (size_t)(nx >> 8) * SEQ + 64 * (nx & 63); const int hn = (nx >> 6) & 3;
#pragma unroll
            for (int i = 0; i < 2; ++i) { const int idx = tid + 512 * i, r = idx >> 4, ch = idx & 15; const bf16_t* p = z + (row0 + r) * EVEN_IN + hn * 128 + ch * 8;
                rq[i] = *(const u32x4*)p; rf[i] = *(const u32x4*)(p + 512);
                const int rv_r = idx & 63, rv_ch = idx >> 6; rv[i] = *(const u32x4*)(z + (row0 + rv_r) * EVEN_IN + 1024 + hn * 128 + rv_ch * 8); } }
        LBAR();
        float kk0[8], kk1[8], bl0[8], bl1[8]; float cum0 = 0.f, cum1 = 0.f;
#pragma unroll
        for (int i = 0; i < 8; ++i) { const int t = 8 * w + i; const unsigned fx2 = *(const unsigned*)(Km + t * 136 + 2 * lane);
            const float fx0 = bflo(fx2), fx1 = bfhi(fx2);
            const float e0 = __expf(-fx0), e1 = __expf(-fx1); const float s0 = __builtin_amdgcn_rcpf(1.0f + e0), s1 = __builtin_amdgcn_rcpf(1.0f + e1);
            const float f0 = lb0 + om0 * s0, f1 = lb1 + om1 * s1;
            cum0 += __logf(fmaxf(f0, 1e-30f)); cum1 += __logf(fmaxf(f1, 1e-30f));
            bl0[i] = cum0; bl1[i] = cum1; kk0[i] = om0 * e0 * s0; kk1[i] = om1 * e1 * s1; }
        segtot[w * 128 + 2 * lane] = cum0; segtot[w * 128 + 2 * lane + 1] = cum1;
        LBAR();
        float off0 = 0.f, off1 = 0.f, mid0 = 0.f, mid1 = 0.f, la0 = 0.f, la1 = 0.f;
#pragma unroll
        for (int s = 0; s < 8; ++s) { const float a0 = segtot[s * 128 + 2 * lane], a1 = segtot[s * 128 + 2 * lane + 1];
            if (s < w) { off0 += a0; off1 += a1; } if (s < 4) { mid0 += a0; mid1 += a1; } la0 += a0; la1 += a1; }
        const float em0 = __expf(mid0), em1 = __expf(mid1), elm0 = __expf(la0 - mid0), elm1 = __expf(la1 - mid1);
        unsigned kd0[4], kd1[4]; float kdprev0 = 0.f, kdprev1 = 0.f;
#pragma unroll
        for (int i = 0; i < 8; ++i) { const int t = 8 * w + i; const unsigned q2 = *(const unsigned*)(Qm + t * 136 + 2 * lane);
            const float q0 = bflo(q2), q1 = bfhi(q2); const float b0 = off0 + bl0[i], b1 = off1 + bl1[i];
            const float qm0 = q0 * __expf(fminf(b0 - mid0, 80.f)), qm1 = q1 * __expf(fminf(b1 - mid1, 80.f));
            const float km0 = kk0[i] * __expf(fminf(mid0 - b0, 80.f)), km1 = kk1[i] * __expf(fminf(mid1 - b1, 80.f));
            const float qt0 = qm0 * em0, qt1 = qm1 * em1;
            const float kdv0 = km0 * elm0, kdv1 = km1 * elm1;
            *(unsigned*)(Qm + t * 136 + 2 * lane) = cvtpk(qm0, qm1); *(unsigned*)(Km + t * 136 + 2 * lane) = cvtpk(km0, km1); *(unsigned*)(Qt + t * 136 + 2 * lane) = cvtpk(qt0, qt1);
            if (i & 1) { kd0[i >> 1] = cvtpk(kdprev0, kdv0); kd1[i >> 1] = cvtpk(kdprev1, kdv1); } else { kdprev0 = kdv0; kdprev1 = kdv1; } }
        { u32x4 t0; t0.x = kd0[0]; t0.y = kd0[1]; t0.z = kd0[2]; t0.w = kd0[3]; *(u32x4*)(KdT + (2 * lane) * 72 + 8 * w) = t0;
          u32x4 t1; t1.x = kd1[0]; t1.y = kd1[1]; t1.z = kd1[2]; t1.w = kd1[3]; *(u32x4*)(KdT + (2 * lane + 1) * 72 + 8 * w) = t1; }
        if (w == 0) { f32x2_t dv = {em0 * elm0, em1 * elm1}; *(f32x2_t*)(DL + (size_t)it * 128 + 2 * lane) = dv; }
        LBAR();
#pragma unroll
        for (int sti = 0; sti < 2; ++sti) { const int st = 2 * eh + sti; f32x4 acc = (f32x4){0.f, 0.f, 0.f, 0.f};
            if (st <= tt) {
#pragma unroll
                for (int ks = 0; ks < 4; ++ks) acc = MFMA16(ldfrag(Qm + (16 * tt + l15) * 136 + 32 * ks + 8 * lg), ldfrag(Km + (16 * st + l15) * 136 + 32 * ks + 8 * lg), acc); }
#pragma unroll
            for (int reg = 0; reg < 4; ++reg) { const int t = 16 * tt + 4 * lg + reg, s = 16 * st + l15; const float v = (st <= tt && s <= t) ? acc[reg] : 0.f; P[t * 72 + s] = cvt1(v); } }
        { const bf16x8 a0 = ldfrag(KdT + (16 * w + l15) * 72 + 8 * lg), a1 = ldfrag(KdT + (16 * w + l15) * 72 + 32 + 8 * lg);
#pragma unroll
          for (int j = 0; j < 8; ++j) { f32x4 sv = (f32x4){0.f, 0.f, 0.f, 0.f};
              sv = MFMA16(a0, ldfrag(vT + (16 * j + l15) * 72 + 8 * lg), sv); sv = MFMA16(a1, ldfrag(vT + (16 * j + l15) * 72 + 32 + 8 * lg), sv);
              u32x2 pk; pk.x = cvtpk(sv[0], sv[1]); pk.y = cvtpk(sv[2], sv[3]); *(u32x2*)(HU + (((size_t)it * 8 + w) * 8 + j) * 256 + lane * 4) = pk; } }
#pragma unroll
        for (int i = 0; i < 2; ++i) { const int idx = tid + 512 * i, r = idx >> 4, ch = idx & 15; *(u32x4*)(QT + (size_t)it * 8192 + r * 128 + ch * 8) = *(const u32x4*)(Qt + r * 136 + ch * 8); }
        LBAR();
        { bf16x8 pa[2];
#pragma unroll
          for (int ks = 0; ks < 2; ++ks) pa[ks] = ldfrag(P + (16 * tt + l15) * 72 + 32 * ks + 8 * lg);
#pragma unroll
          for (int j = 0; j < 4; ++j) { const int et = 4 * eh + j; f32x4 acc = (f32x4){0.f, 0.f, 0.f, 0.f};
#pragma unroll
              for (int ks = 0; ks < 2; ++ks) acc = MFMA16(pa[ks], ldfrag(vT + (16 * et + l15) * 72 + 32 * ks + 8 * lg), acc);
              u32x2 pk; pk.x = cvtpk(acc[0], acc[1]); pk.y = cvtpk(acc[2], acc[3]); *(u32x2*)(OI + (((size_t)it * 4 + tt) * 8 + et) * 256 + lane * 4) = pk; } }
        LBAR();
    }
    __syncthreads();
}

struct HgrnSet { u32x4 q[2]; u32x2 u[2]; u32x2 oi; f32x4 dl; };
__device__ __forceinline__ void hgrn_s2_load(HgrnSet& s, int it, const unsigned char* ws, const unsigned char* hb, int tid, int lane, int w, int lg, int tt, int et, int eq) {
    const bf16_t* QT = (const bf16_t*)(hb + OUT_HQT); const bf16_t* HU = (const bf16_t*)(hb + OUT_HU); const bf16_t* OI = (const bf16_t*)(hb + OUT_HOI); const float* DL = (const float*)(ws + WS_HDL);
#pragma unroll
    for (int i = 0; i < 2; ++i) { const int idx = tid + 512 * i, r = idx >> 4, ch = idx & 15; s.q[i] = *(const u32x4*)(QT + (size_t)it * 8192 + r * 128 + ch * 8); }
#pragma unroll
    for (int jj = 0; jj < 2; ++jj) s.u[jj] = *(const u32x2*)(HU + (((size_t)it * 8 + w) * 8 + 2 * eq + jj) * 256 + lane * 4);
    s.oi = *(const u32x2*)(OI + (((size_t)it * 4 + tt) * 8 + 2 * eq + et) * 256 + lane * 4);
    s.dl = *(const f32x4*)(DL + (size_t)it * 128 + 16 * w + 4 * lg);
}
__device__ __forceinline__ void hgrn_s2_chunk(HgrnSet& s, f32x4 (&S)[2], int it, bool more, unsigned char* lds, const unsigned char* ws, const unsigned char* hb, bf16_t* yrow, int tid, int lane, int w, int l15, int lg, int tt, int et, int eq) {
    bf16_t* Qts = (bf16_t*)(lds + 0);
    bf16_t* ST2 = (bf16_t*)(lds + 17408);
    bf16_t* O2s = (bf16_t*)(lds + 26112);
#pragma unroll
    for (int i = 0; i < 2; ++i) { const int idx = tid + 512 * i, r = idx >> 4, ch = idx & 15; *(u32x4*)(Qts + r * 136 + ch * 8) = s.q[i]; }
#pragma unroll
    for (int jj = 0; jj < 2; ++jj) { u32x2 pk; pk.x = cvtpk(S[jj][0], S[jj][1]); pk.y = cvtpk(S[jj][2], S[jj][3]); *(u32x2*)(ST2 + (16 * jj + l15) * 136 + 16 * w + 4 * lg) = pk; }
    const u32x2 u0 = s.u[0], u1 = s.u[1], oi = s.oi; const f32x4 dl = s.dl;
    if (more) hgrn_s2_load(s, it + 4, ws, hb, tid, lane, w, lg, tt, et, eq);
    LBAR();
    f32x4 acc = (f32x4){0.f, 0.f, 0.f, 0.f};
#pragma unroll
    for (int ks = 0; ks < 4; ++ks) acc = MFMA16(ldfrag(Qts + (16 * tt + l15) * 136 + 32 * ks + 8 * lg), ldfrag(ST2 + (16 * et + l15) * 136 + 32 * ks + 8 * lg), acc);
    const float o0 = acc[0] + bflo(oi.x), o1 = acc[1] + bfhi(oi.x), o2 = acc[2] + bflo(oi.y), o3 = acc[3] + bfhi(oi.y);
    O2s[(16 * tt + 4 * lg + 0) * 40 + 16 * et + l15] = cvt1(o0); O2s[(16 * tt + 4 * lg + 1) * 40 + 16 * et + l15] = cvt1(o1);
    O2s[(16 * tt + 4 * lg + 2) * 40 + 16 * et + l15] = cvt1(o2); O2s[(16 * tt + 4 * lg + 3) * 40 + 16 * et + l15] = cvt1(o3);
    S[0][0] = dl[0] * S[0][0] + bflo(u0.x); S[0][1] = dl[1] * S[0][1] + bfhi(u0.x); S[0][2] = dl[2] * S[0][2] + bflo(u0.y); S[0][3] = dl[3] * S[0][3] + bfhi(u0.y);
    S[1][0] = dl[0] * S[1][0] + bflo(u1.x); S[1][1] = dl[1] * S[1][1] + bfhi(u1.x); S[1][2] = dl[2] * S[1][2] + bflo(u1.y); S[1][3] = dl[3] * S[1][3] + bfhi(u1.y);
    LBAR();
    if (tid < 256) { const int r = tid >> 2, ch = tid & 3; *(u32x4*)(yrow + (size_t)r * DM + ch * 8) = *(const u32x4*)(O2s + r * 40 + ch * 8); }
}
__device__ __forceinline__ void hgrn_s2(unsigned char* lds, int blk, const unsigned char* ws, const unsigned char* hb, bf16_t* y) {
    int tid_ = threadIdx.x; asm volatile("" : "+v"(tid_));
    const int tid = tid_, lane = tid & 63, w = tid >> 6, l15 = lane & 15, lg = lane >> 4;
    const int b = blk >> 4, h = (blk >> 2) & 3, eq = blk & 3, tt = w >> 1, et = w & 1;
    const int it0 = (b * 4 + h) * 64;
    f32x4 S[2]; S[0] = (f32x4){0.f, 0.f, 0.f, 0.f}; S[1] = (f32x4){0.f, 0.f, 0.f, 0.f};
    HgrnSet s0, s1, s2, s3;
    hgrn_s2_load(s0, it0 + 0, ws, hb, tid, lane, w, lg, tt, et, eq); hgrn_s2_load(s1, it0 + 1, ws, hb, tid, lane, w, lg, tt, et, eq);
    hgrn_s2_load(s2, it0 + 2, ws, hb, tid, lane, w, lg, tt, et, eq); hgrn_s2_load(s3, it0 + 3, ws, hb, tid, lane, w, lg, tt, et, eq);
    bf16_t* ybase = y + ((size_t)b * SEQ) * DM + h * 128 + 32 * eq;
    for (int c = 0; c < 64; c += 4) {
        const bool more = (c + 4 < 64);
        hgrn_s2_chunk(s0, S, it0 + c + 0, more, lds, ws, hb, ybase + (size_t)(64 * (c + 0)) * DM, tid, lane, w, l15, lg, tt, et, eq);
        hgrn_s2_chunk(s1, S, it0 + c + 1, more, lds, ws, hb, ybase + (size_t)(64 * (c + 1)) * DM, tid, lane, w, l15, lg, tt, et, eq);
        hgrn_s2_chunk(s2, S, it0 + c + 2, more, lds, ws, hb, ybase + (size_t)(64 * (c + 2)) * DM, tid, lane, w, l15, lg, tt, et, eq);
        hgrn_s2_chunk(s3, S, it0 + c + 3, more, lds, ws, hb, ybase + (size_t)(64 * (c + 3)) * DM, tid, lane, w, l15, lg, tt, et, eq);
    }
    __syncthreads();
}

__device__ __forceinline__ void hgrn_s3(int G, int bid, const bf16_t* z, bf16_t* y, const float* gn) {
    int tid_ = threadIdx.x; asm volatile("" : "+v"(tid_));
    const int tid = tid_, lane = tid & 63, wave = tid >> 6;
    const int gw = bid * NWAVES + wave, NGW = G * NWAVES;
    const f32x4 g0 = *(const f32x4*)(gn + lane * 8), g1 = *(const f32x4*)(gn + lane * 8 + 4);
    const bool xa = (G == 256);
    for (int row = xa ? ((bid & 7) * 4096 + (bid >> 3) * 8 + wave) : gw; row < (xa ? (bid & 7) * 4096 + 4096 : M_TOK); row += (xa ? 256 : NGW)) {
        const u32x4 ov = *(const u32x4*)(y + (size_t)row * DM + lane * 8); const u32x4 gv = *(const u32x4*)(z + (size_t)row * EVEN_IN + 1536 + lane * 8);
        float o[8], ga[8];
        o[0] = bflo(ov.x); o[1] = bfhi(ov.x); o[2] = bflo(ov.y); o[3] = bfhi(ov.y); o[4] = bflo(ov.z); o[5] = bfhi(ov.z); o[6] = bflo(ov.w); o[7] = bfhi(ov.w);
        ga[0] = bflo(gv.x); ga[1] = bfhi(gv.x); ga[2] = bflo(gv.y); ga[3] = bfhi(gv.y); ga[4] = bflo(gv.z); ga[5] = bfhi(gv.z); ga[6] = bflo(gv.w); ga[7] = bfhi(gv.w);
        float ss = 0.f;
#pragma unroll
        for (int k = 0; k < 8; ++k) ss += o[k] * o[k];
        ss = red16_sum(ss);
        const float rs = rsqrtf(ss * (1.0f / 128.0f) + 1e-6f);
        float r[8];
#pragma unroll
        for (int k = 0; k < 8; ++k) { const float gk = (k < 4) ? g0[k & 3] : g1[k & 3]; r[k] = o[k] * rs * gk * (ga[k] * __builtin_amdgcn_rcpf(1.0f + __expf(-ga[k]))); }
        u32x4 wv; wv.x = cvtpk(r[0], r[1]); wv.y = cvtpk(r[2], r[3]); wv.z = cvtpk(r[4], r[5]); wv.w = cvtpk(r[6], r[7]);
        *(u32x4*)(y + (size_t)row * DM + lane * 8) = wv;
    }
}

__device__ __forceinline__ void rglru_item(unsigned char* lds, int b, int n, int jq, const bf16_t* z, bf16_t* y, const float* conv_w, const float* conv_b,
                                           const float* wa, const float* ba, const float* wx, const float* bx, const float* lam) {
    int tid_ = threadIdx.x; asm volatile("" : "+v"(tid_));
    const int tid = tid_, lane = tid & 63, w = tid >> 6, l15 = lane & 15, lg = lane >> 4;
    bf16_t* raw = (bf16_t*)(lds);
    bf16_t* Wt = (bf16_t*)(lds + 37440);
    float* G = (float*)(lds + 55872);
    float* AH = (float*)(lds + 89664);
    for (int idx = tid; idx < 4 * 32 * 64; idx += NTHREADS) { const int tap = idx >> 11, jj = (idx >> 6) & 31, i = idx & 63;
        const float v = (jj < 16) ? wa[((size_t)n * 64 + i) * 64 + 16 * jq + jj] : wx[((size_t)n * 64 + i) * 64 + 16 * jq + jj - 16];
        Wt[(tap * 32 + jj) * 72 + i] = cvt1(v * conv_w[tap * 512 + 64 * n + i]); }
    const int j = tid & 15, seg = tid >> 4;
    const int cch = 64 * n + 16 * jq + j;
    float bav = ba[cch], bxv = bx[cch];
    for (int i = 0; i < 64; ++i) { const float cbi = conv_b[64 * n + i]; bav += cbi * wa[((size_t)n * 64 + i) * 64 + 16 * jq + j]; bxv += cbi * wx[((size_t)n * 64 + i) * 64 + 16 * jq + j]; }
    const float c8 = -8.0f * log1pf(expf(-lam[cch]));
    const float cw0 = conv_w[cch], cw1 = conv_w[512 + cch], cw2 = conv_w[1024 + cch], cw3 = conv_w[1536 + cch], cbv = conv_b[cch];
    const int o8 = tid & 7;
    float h_in = 0.f;
    const size_t rowb = (size_t)b * SEQ;
#define RG_GLD(dst, p) asm volatile("global_load_dwordx4 %0, %1, off" : "=v"(dst) : "v"(p) : "memory")
    u32x4 rr[5];
#pragma unroll
    for (int i = 0; i < 5; ++i) { const int idx = tid + 512 * i; const int r = (idx < 259 * 8) ? (idx >> 3) : 258; const int tok = (r >= 3) ? r - 3 : 0;
        const bf16_t* p_ = z + (rowb + tok) * EVEN_IN + 2560 + 64 * n + o8 * 8; RG_GLD(rr[i], p_); }
    for (int tile = 0; tile < 16; ++tile) {
        const int t0 = tile * 256;
        if (tile == 0) { asm volatile("s_waitcnt vmcnt(0)" : "+v"(rr[0]), "+v"(rr[1]), "+v"(rr[2]), "+v"(rr[3]), "+v"(rr[4]) : : "memory"); if (tid < 24) rr[0] = (u32x4){0u, 0u, 0u, 0u}; }
        else asm volatile("s_waitcnt vmcnt(8)" : "+v"(rr[0]), "+v"(rr[1]), "+v"(rr[2]), "+v"(rr[3]), "+v"(rr[4]) : : "memory");
#pragma unroll
        for (int i = 0; i < 5; ++i) { const int idx = tid + 512 * i, r = idx >> 3; if (idx < 259 * 8) *(u32x4*)(raw + r * 72 + o8 * 8) = rr[i]; }
        if (tile + 1 < 16) {
#pragma unroll
            for (int i = 0; i < 5; ++i) { const int idx = tid + 512 * i; const int r = (idx < 259 * 8) ? (idx >> 3) : 258; const bf16_t* p_ = z + (rowb + t0 + 256 - 3 + r) * EVEN_IN + 2560 + 64 * n + o8 * 8; RG_GLD(rr[i], p_); } }
        unsigned gb[8];
#pragma unroll
        for (int i = 0; i < 8; ++i) gb[i] = z[(rowb + t0 + 8 * seg + i) * EVEN_IN + 2048 + cch];
        LBAR();
#pragma unroll
        for (int mi = 0; mi < 2; ++mi) { const int mt = 2 * w + mi;
            f32x4 acc0 = (f32x4){0.f, 0.f, 0.f, 0.f}, acc1 = (f32x4){0.f, 0.f, 0.f, 0.f};
#pragma unroll
            for (int tap = 0; tap < 4; ++tap) {
                const bf16x8 a0 = ldfrag(raw + (16 * mt + l15 + tap) * 72 + 8 * lg), a1 = ldfrag(raw + (16 * mt + l15 + tap) * 72 + 32 + 8 * lg);
                acc0 = MFMA16(a0, ldfrag(Wt + (tap * 32 + l15) * 72 + 8 * lg), acc0); acc0 = MFMA16(a1, ldfrag(Wt + (tap * 32 + l15) * 72 + 32 + 8 * lg), acc0);
                acc1 = MFMA16(a0, ldfrag(Wt + (tap * 32 + 16 + l15) * 72 + 8 * lg), acc1); acc1 = MFMA16(a1, ldfrag(Wt + (tap * 32 + 16 + l15) * 72 + 32 + 8 * lg), acc1); }
#pragma unroll
            for (int reg = 0; reg < 4; ++reg) { G[(16 * mt + 4 * lg + reg) * 33 + l15] = acc0[reg]; G[(16 * mt + 4 * lg + reg) * 33 + 16 + l15] = acc1[reg]; } }
        LBAR();
        float av[8], uv[8]; float Ac = 1.f, Hc = 0.f;
#pragma unroll
        for (int i = 0; i < 8; ++i) { const int t = 8 * seg + i;
            const float gr = G[t * 33 + j] + bav, gi = G[t * 33 + 16 + j] + bxv;
            const float r = __builtin_amdgcn_rcpf(1.0f + __expf(-gr)), ig = __builtin_amdgcn_rcpf(1.0f + __expf(-gi));
            const float la = c8 * r; const float aa = __expf(la); const float t2 = 2.0f * la;
            const float om = (t2 > -0.02f) ? -(t2 + 0.5f * t2 * t2 + 0.16666667f * t2 * t2 * t2) : (1.0f - aa * aa);
            const float m2 = __builtin_amdgcn_sqrtf(fmaxf(om, 0.f));
            const int cl = 16 * jq + j;
            const float xf = cbv + cw0 * bf2f(raw[(t + 0) * 72 + cl]) + cw1 * bf2f(raw[(t + 1) * 72 + cl]) + cw2 * bf2f(raw[(t + 2) * 72 + cl]) + cw3 * bf2f(raw[(t + 3) * 72 + cl]);
            const float u = m2 * (ig * xf);
            av[i] = aa; uv[i] = u; Ac *= aa; Hc = aa * Hc + u; }
        AH[(seg * 16 + j) * 2] = Ac; AH[(seg * 16 + j) * 2 + 1] = Hc;
        LBAR();
        float cur = h_in, hs = 0.f;
#pragma unroll
        for (int s = 0; s < 32; ++s) { const f32x2_t ah = *(const f32x2_t*)(AH + (s * 16 + j) * 2); if (s == seg) hs = cur; cur = ah.x * cur + ah.y; }
        float hh = hs;
#pragma unroll
        for (int i = 0; i < 8; ++i) { hh = av[i] * hh + uv[i]; const float g = bf2f(gb[i]);
            const float u = 0.7978845608028654f * (g + 0.044715f * g * g * g); const float th = 1.0f - 2.0f * __builtin_amdgcn_rcpf(1.0f + __expf(2.0f * u));
            const float ge = 0.5f * g * (1.0f + th);
            y[(rowb + t0 + 8 * seg + i) * DM + 512 + cch] = cvt1(hh * ge); }
        h_in = cur;
    }
    __syncthreads();
}

__device__ __forceinline__ void qk_rot(const u32x4 r1, const u32x4 r2, const f32x4 g1a, const f32x4 g1b, const f32x4 g2a, const f32x4 g2b, const f32x4 ca, const f32x4 cb, const f32x4 sa, const f32x4 sb, int p, float scale, bf16_t* dst) {
    float x1[8], x2[8];
    x1[0] = bflo(r1.x); x1[1] = bfhi(r1.x); x1[2] = bflo(r1.y); x1[3] = bfhi(r1.y); x1[4] = bflo(r1.z); x1[5] = bfhi(r1.z); x1[6] = bflo(r1.w); x1[7] = bfhi(r1.w);
    x2[0] = bflo(r2.x); x2[1] = bfhi(r2.x); x2[2] = bflo(r2.y); x2[3] = bfhi(r2.y); x2[4] = bflo(r2.z); x2[5] = bfhi(r2.z); x2[6] = bflo(r2.w); x2[7] = bfhi(r2.w);
    float ss = 0.f;
#pragma unroll
    for (int i = 0; i < 8; ++i) ss += x1[i] * x1[i] + x2[i] * x2[i];
    ss += __shfl_xor(ss, 1); ss += __shfl_xor(ss, 2);
    const float rs = rsqrtf(ss * (1.0f / 64.0f) + 1e-6f) * scale;
    float o1[8], o2[8];
#pragma unroll
    for (int i = 0; i < 8; ++i) { const float c = (i < 4) ? ca[i & 3] : cb[i & 3], sn = (i < 4) ? sa[i & 3] : sb[i & 3];
        const float g1 = (i < 4) ? g1a[i & 3] : g1b[i & 3], g2 = (i < 4) ? g2a[i & 3] : g2b[i & 3];
        const float y1 = x1[i] * rs * g1, y2 = x2[i] * rs * g2;
        o1[i] = y1 * c - y2 * sn; o2[i] = y2 * c + y1 * sn; }
    u32x4 w1, w2; w1.x = cvtpk(o1[0], o1[1]); w1.y = cvtpk(o1[2], o1[3]); w1.z = cvtpk(o1[4], o1[5]); w1.w = cvtpk(o1[6], o1[7]);
    w2.x = cvtpk(o2[0], o2[1]); w2.y = cvtpk(o2[2], o2[3]); w2.z = cvtpk(o2[4], o2[5]); w2.w = cvtpk(o2[6], o2[7]);
    *(u32x4*)(dst + 8 * p) = w1; *(u32x4*)(dst + 32 + 8 * p) = w2;
}

__device__ __forceinline__ void swa_item(unsigned char* lds, int b, int n, int kvh, const bf16_t* z, bf16_t* y, const float* cosT, const float* sinT,
                                         const float* qn, const float* kn, const float* sinks) {
    int tid_ = threadIdx.x; asm volatile("" : "+v"(tid_));
    const int tid = tid_, lane = tid & 63, w = tid >> 6, l15 = lane & 15, lg = lane >> 4;
    bf16_t* Ks = (bf16_t*)lds;
    bf16_t* VT = (bf16_t*)(lds + 36864);
    bf16_t* Qs = (bf16_t*)(lds + 72704);
    bf16_t* Pw = (bf16_t*)(lds + 91136) + w * (16 * 168);
    const size_t tok0 = (size_t)b * SEQ + 128 * n;
    const int prow = tid >> 2, pp = tid & 3;
    const bool first = (n == 0);
    const u32x4 zz = (u32x4){0u, 0u, 0u, 0u}; const f32x4 zf = (f32x4){0.f, 0.f, 0.f, 0.f};
    u32x4 k0a = zz, k0b = zz; f32x4 c0a = zf, c0b = zf, s0a = zf, s0b = zf;
    if (!first) { const size_t tok = tok0 - 128 + prow; const bf16_t* kp = z + tok * ODD_IN + 1024 + kvh * 64;
        k0a = *(const u32x4*)(kp + 8 * pp); k0b = *(const u32x4*)(kp + 32 + 8 * pp);
        c0a = *(const f32x4*)(cosT + tok * 32 + 8 * pp); c0b = *(const f32x4*)(cosT + tok * 32 + 8 * pp + 4); s0a = *(const f32x4*)(sinT + tok * 32 + 8 * pp); s0b = *(const f32x4*)(sinT + tok * 32 + 8 * pp + 4); }
    const size_t tokq = tok0 + prow;
    const bf16_t* kp1 = z + tokq * ODD_IN + 1024 + kvh * 64;
    const u32x4 k1a = *(const u32x4*)(kp1 + 8 * pp), k1b = *(const u32x4*)(kp1 + 32 + 8 * pp);
    const f32x4 c1a = *(const f32x4*)(cosT + tokq * 32 + 8 * pp), c1b = *(const f32x4*)(cosT + tokq * 32 + 8 * pp + 4), s1a = *(const f32x4*)(sinT + tokq * 32 + 8 * pp), s1b = *(const f32x4*)(sinT + tokq * 32 + 8 * pp + 4);
    u32x4 vv[4];
#pragma unroll
    for (int i = 0; i < 4; ++i) { const int idx = tid + 512 * i, r = idx & 255, c8 = idx >> 8; vv[i] = zz;
        if (!(first && r < 128)) vv[i] = *(const u32x4*)(z + (tok0 - 128 + r) * ODD_IN + 1280 + kvh * 64 + c8 * 8); }
    const f32x4 kg1a = *(const f32x4*)(kn + 8 * pp), kg1b = *(const f32x4*)(kn + 8 * pp + 4), kg2a = *(const f32x4*)(kn + 32 + 8 * pp), kg2b = *(const f32x4*)(kn + 32 + 8 * pp + 4);
    f32x4 qg1a = *(const f32x4*)(qn + 8 * pp), qg1b = *(const f32x4*)(qn + 8 * pp + 4), qg2a = *(const f32x4*)(qn + 32 + 8 * pp), qg2b = *(const f32x4*)(qn + 32 + 8 * pp + 4);
    float sinkv[4];
#pragma unroll
    for (int g = 0; g < 4; ++g) sinkv[g] = sinks[kvh * 4 + g];
    u32x4 qa_[4], qb_[4];
#pragma unroll
    for (int g = 0; g < 4; ++g) { const bf16_t* qp = z + tokq * ODD_IN + (kvh * 4 + g) * 64; qa_[g] = *(const u32x4*)(qp + 8 * pp); qb_[g] = *(const u32x4*)(qp + 32 + 8 * pp); }
    if (first) { *(u32x4*)(Ks + prow * 72 + 8 * pp) = zz; *(u32x4*)(Ks + prow * 72 + 32 + 8 * pp) = zz; }
    else qk_rot(k0a, k0b, kg1a, kg1b, kg2a, kg2b, c0a, c0b, s0a, s0b, pp, 1.0f, Ks + prow * 72);
    qk_rot(k1a, k1b, kg1a, kg1b, kg2a, kg2b, c1a, c1b, s1a, s1b, pp, 1.0f, Ks + (128 + prow) * 72);
#pragma unroll
    for (int i = 0; i < 4; ++i) { const int idx = tid + 512 * i, r = idx & 255, c8 = idx >> 8; const u32x4 v = vv[i];
        VT[(c8 * 8 + 0) * 280 + r] = (bf16_t)(v.x & 0xffffu); VT[(c8 * 8 + 1) * 280 + r] = (bf16_t)(v.x >> 16);
        VT[(c8 * 8 + 2) * 280 + r] = (bf16_t)(v.y & 0xffffu); VT[(c8 * 8 + 3) * 280 + r] = (bf16_t)(v.y >> 16);
        VT[(c8 * 8 + 4) * 280 + r] = (bf16_t)(v.z & 0xffffu); VT[(c8 * 8 + 5) * 280 + r] = (bf16_t)(v.z >> 16);
        VT[(c8 * 8 + 6) * 280 + r] = (bf16_t)(v.w & 0xffffu); VT[(c8 * 8 + 7) * 280 + r] = (bf16_t)(v.w >> 16); }
    for (int idx = tid; idx < 64 * 24; idx += NTHREADS) VT[(idx / 24) * 280 + 256 + (idx % 24)] = 0;
    asm volatile("s_waitcnt vmcnt(0)" : "+v"(qa_[0]), "+v"(qa_[1]), "+v"(qa_[2]), "+v"(qa_[3]), "+v"(qb_[0]), "+v"(qb_[1]), "+v"(qb_[2]), "+v"(qb_[3]), "+v"(qg1a), "+v"(qg1b), "+v"(qg2a), "+v"(qg2b) : : "memory");
    asm volatile("" : "+v"(sinkv[0]), "+v"(sinkv[1]), "+v"(sinkv[2]), "+v"(sinkv[3]));
#pragma unroll
    for (int g = 0; g < 4; ++g) {
        const int hq = kvh * 4 + g;
        LBAR();
        qk_rot(qa_[g], qb_[g], qg1a, qg1b, qg2a, qg2b, c1a, c1b, s1a, s1b, pp, 0.125f, Qs + prow * 72);
        LBAR();
        const float sink = sinkv[g];
        const bf16x8 qf0 = ldfrag(Qs + (16 * w + l15) * 72 + 8 * lg), qf1 = ldfrag(Qs + (16 * w + l15) * 72 + 32 + 8 * lg);
        f32x4 sc[9];
#pragma unroll
        for (int kt = 0; kt < 9; ++kt) { const int kr = 16 * (w + kt) + l15; f32x4 acc = (f32x4){0.f, 0.f, 0.f, 0.f};
            acc = MFMA16(ldfrag(Ks + kr * 72 + 8 * lg), qf0, acc); acc = MFMA16(ldfrag(Ks + kr * 72 + 32 + 8 * lg), qf1, acc); sc[kt] = acc; }
        float m = -1e30f;
#pragma unroll
        for (int kt = 0; kt < 9; ++kt) {
            const bool tile_ok = !first || (w + kt >= 8);
#pragma unroll
            for (int reg = 0; reg < 4; ++reg) { const int dlt = l15 - 4 * lg - reg;
                bool valid = tile_ok; if (kt == 0) valid = valid && (dlt < 0); if (kt == 8) valid = valid && (dlt >= 0);
                const float v = valid ? sc[kt][reg] : -1e30f; sc[kt][reg] = v; m = fmaxf(m, v); } }
        m = fmaxf(m, __shfl_xor(m, 16)); m = fmaxf(m, __shfl_xor(m, 32)); m = fmaxf(m, sink);
        float sm = 0.f;
#pragma unroll
        for (int kt = 0; kt < 9; ++kt)
#pragma unroll
            for (int reg = 0; reg < 4; ++reg) { const float p = __expf(sc[kt][reg] - m); sc[kt][reg] = p; sm += p; }
        sm += __shfl_xor(sm, 16); sm += __shfl_xor(sm, 32);
        const float invq = __builtin_amdgcn_rcpf(sm + __expf(sink - m));
        float inv[4];
#pragma unroll
        for (int reg = 0; reg < 4; ++reg) inv[reg] = __shfl(invq, 4 * lg + reg);
        bf16x8 pa[5];
#pragma unroll
        for (int ks = 0; ks < 5; ++ks) { u32x4 pw; pw.x = cvtpk(sc[2 * ks][0], sc[2 * ks][1]); pw.y = cvtpk(sc[2 * ks][2], sc[2 * ks][3]);
            if (ks < 4) { pw.z = cvtpk(sc[2 * ks + 1][0], sc[2 * ks + 1][1]); pw.w = cvtpk(sc[2 * ks + 1][2], sc[2 * ks + 1][3]); } else { pw.z = 0u; pw.w = 0u; }
            pa[ks] = __builtin_bit_cast(bf16x8, pw); }
#pragma unroll
        for (int dt = 0; dt < 4; ++dt) { f32x4 acc = (f32x4){0.f, 0.f, 0.f, 0.f};
#pragma unroll
            for (int ks = 0; ks < 5; ++ks) { const bf16_t* vp = VT + (16 * dt + l15) * 280 + 16 * w + 32 * ks + 4 * lg;
                u32x4 bw; const u32x2 lo = *(const u32x2*)vp, hi = *(const u32x2*)(vp + 16); bw.x = lo.x; bw.y = lo.y; bw.z = hi.x; bw.w = hi.y;
                acc = MFMA16(pa[ks], __builtin_bit_cast(bf16x8, bw), acc); }
#pragma unroll
            for (int reg = 0; reg < 4; ++reg) y[(tok0 + 16 * w + 4 * lg + reg) * DM + hq * 64 + 16 * dt + l15] = cvt1(acc[reg] * inv[reg]); }
    }
    LBAR();
}

#define XB_TMO      128
#define XB_XCNT(j)  (256  + 64 * (j))
#define XB_XSUB(j)  (1280 + 64 * (j))
#define XB_XGEN(j)  (2304 + 64 * (j))
#define XB_TOP      3328
#define XB_TOPGEN   3392
#define XCD_BAR_WORDS 3456
#define XB_SPIN_CAP (1u << 18)

__device__ __forceinline__ unsigned xb_ld(unsigned* p)              { return __hip_atomic_load(p, __ATOMIC_RELAXED, __HIP_MEMORY_SCOPE_AGENT); }
__device__ __forceinline__ unsigned xb_add(unsigned* p, unsigned v) { return __hip_atomic_fetch_add(p, v, __ATOMIC_RELAXED, __HIP_MEMORY_SCOPE_AGENT); }
__device__ __forceinline__ unsigned xb_xcc_id() { return (unsigned)__builtin_amdgcn_s_getreg((3 << 11) | 20) & 0xFu; }
#define XB_SPIN(cond, bar) do { unsigned _sp = 0; while (cond) { __builtin_amdgcn_s_sleep(1); \
    if ((++_sp & 255u) == 0u) { if (xb_ld(&(bar)[XB_TMO])) break; if (_sp > XB_SPIN_CAP) { atomicAdd(&(bar)[XB_TMO], 1u); break; } } } } while (0)

struct XcdBarrier {
    unsigned* bar; unsigned x;
    volatile LAS unsigned* st;
};

__device__ __forceinline__ XcdBarrier xcd_barrier_post(unsigned* bar, volatile LAS unsigned* st) {
    XcdBarrier b; b.bar = bar; b.x = xb_xcc_id(); b.st = st;
    if (threadIdx.x == 0) (void)xb_add(&bar[XB_XCNT(b.x)], 1u);
    return b;
}
__device__ __forceinline__ void xcd_barrier_complete(unsigned* bar, unsigned x, unsigned& nloc, unsigned& nx) {
    const unsigned G = gridDim.x * gridDim.y * gridDim.z;
    unsigned sum, cnt, mine, sp = 0u;
    for (;;) {
        sum = 0u; cnt = 0u; mine = 0u;
#pragma unroll
        for (unsigned j = 0; j < 16; ++j) { const unsigned c = xb_ld(&bar[XB_XCNT(j)]); sum += c; cnt += (c > 0u) ? 1u : 0u; mine = (j == x) ? c : mine; }
        if (sum == G) break;
        __builtin_amdgcn_s_sleep(1);
        if ((++sp & 255u) == 0u) { if (xb_ld(&bar[XB_TMO])) break; if (sp > XB_SPIN_CAP) { atomicAdd(&bar[XB_TMO], 1u); break; } }
    }
    nloc = mine > 0u ? mine : 1u; nx = cnt > 0u ? cnt : 1u;
}

__device__ __forceinline__ void xcd_barrier(const XcdBarrier& b) {
    asm volatile("s_waitcnt vmcnt(0)" ::: "memory");
    __syncthreads();
    if (threadIdx.x == 0) {
        unsigned* bar = b.bar;
        __builtin_amdgcn_s_waitcnt(0);
        unsigned nloc = b.st[0], nx = b.st[1];
        if (nloc == 0u) { xcd_barrier_complete(bar, b.x, nloc, nx); b.st[0] = nloc; b.st[1] = nx; }
        const unsigned old = xb_add(&bar[XB_XSUB(b.x)], 1u);
        const unsigned gen = old / nloc;
        if (old + 1u == (gen + 1u) * nloc) {
            __builtin_amdgcn_fence(__ATOMIC_RELEASE, "agent");
            asm volatile("s_waitcnt vmcnt(0)" ::: "memory");
            const unsigned og = xb_add(&bar[XB_TOP], 1u);
            const unsigned tg = og / nx;
            if (og + 1u == (tg + 1u) * nx) xb_add(&bar[XB_TOPGEN], 1u);
            else XB_SPIN(xb_ld(&bar[XB_TOPGEN]) == tg, bar);
            __builtin_amdgcn_fence(__ATOMIC_ACQUIRE, "agent");
            xb_add(&bar[XB_XGEN(b.x)], 1u);
            asm volatile("s_waitcnt vmcnt(0)" ::: "memory");
        } else {
            XB_SPIN(xb_ld(&bar[XB_XGEN(b.x)]) == gen, bar);
            __builtin_amdgcn_fence(__ATOMIC_ACQUIRE, "agent");
            asm volatile("s_waitcnt vmcnt(0)" ::: "memory");
        }
    }
    __syncthreads();
}

__device__ __forceinline__ void xcd_local_barrier(const XcdBarrier& b, unsigned* lbar) {
    asm volatile("s_waitcnt vmcnt(0)" ::: "memory");
    __syncthreads();
    if (threadIdx.x == 0) {
        __builtin_amdgcn_s_waitcnt(0);
        const unsigned nloc = b.st[0];
        const unsigned old = xb_add(&lbar[XB_XSUB(b.x)], 1u);
        const unsigned gen = old / nloc;
        if (old + 1u == (gen + 1u) * nloc) xb_add(&lbar[XB_XGEN(b.x)], 1u);
        else XB_SPIN(xb_ld(&lbar[XB_XGEN(b.x)]) == gen, lbar);
        __builtin_amdgcn_fence(__ATOMIC_ACQUIRE, "agent");
        asm volatile("s_waitcnt vmcnt(0)" ::: "memory");
    }
    __syncthreads();
}

#ifndef MK_MULTI
#define MK_MULTI 0
#endif
#define PROBE_DUP 0
__global__ void __launch_bounds__(NTHREADS, 2) trunk_fwd(Args a) {
    extern __shared__ __attribute__((aligned(16))) unsigned char lds[];
    cg::grid_group grid = cg::this_grid();
    const int G = gridDim.x, bid = blockIdx.x;
    unsigned char* ws = a.ws;
    float* rowsq = (float*)(ws + WS_ROWSQ);
    bf16_t* XB = (bf16_t*)(ws + WS_XB); bf16_t* XLO = (bf16_t*)(ws + WS_LO); bf16_t* HID = (bf16_t*)(ws + WS_HID);
    const bool grp = (G == 256); const size_t gb = (size_t)(bid & 7);
    bf16_t* Zev = grp ? (bf16_t*)(ws + WS_Z + gb * (8 * MiB)) : (bf16_t*)(ws + WS_Z);
    bf16_t* Zod = grp ? (bf16_t*)(ws + WS_Z + gb * (20 * MiB)) : (bf16_t*)(ws + WS_Z);
    bf16_t* Y = grp ? (bf16_t*)(ws + WS_Z + 24 * MiB + gb * (24 * MiB)) : (bf16_t*)(ws + WS_Y);
    const float* cosT = (const float*)(ws + WS_COS); const float* sinT = (const float*)(ws + WS_SIN);
    const int lo = a.ph_lo, hi = a.ph_hi;
#define IN(k) (lo <= (k) && (k) < hi)
    { volatile LAS unsigned* st = (volatile LAS unsigned*)((LAS unsigned char*)lds + (LDS_BYTES - 64)); if (threadIdx.x < 2) st[threadIdx.x] = 0u; }
    __syncthreads();
    XcdBarrier bar = xcd_barrier_post((unsigned*)(ws + WS_BAR), (volatile LAS unsigned*)((LAS unsigned char*)lds + (LDS_BYTES - 64)));
    unsigned* lbar = (unsigned*)(ws + WS_BAR) + XCD_BAR_WORDS;
    if (threadIdx.x == 0) { if (!grp) (void)xb_add(&lbar[0], 1u); __hip_atomic_fetch_or(&lbar[16 + (bid & 7)], 1u << bar.x, __ATOMIC_RELAXED, __HIP_MEMORY_SCOPE_AGENT); }
    bool use_local = false;
    const int last_seam = N_PHASES - 2;
#define SEAM(k) do { if (IN(k) && IN((k) + 1)) { if (use_local && (k) != 0 && (k) != last_seam) xcd_local_barrier(bar, lbar); else xcd_barrier(bar); \
        if ((k) == 0) { unsigned all_ = 0u; bool one_ = true; for (int g_ = 0; g_ < 8; ++g_) { const unsigned m_ = xb_ld(&lbar[16 + g_]); one_ = one_ && (__builtin_popcount(m_) == 1); all_ |= m_; } \
            use_local = (xb_ld(&lbar[0]) == 0u) && one_ && (__builtin_popcount(all_) == 8); } } } while (0)
    if (a.ph_hi < 0) grid.sync();
#ifndef NO_P0
    if (IN(0)) { for (int rep = 0; rep < (PROBE_DUP == 4 ? 2 : 1); ++rep) { p0_prologue(a, lds); __syncthreads(); } }
#endif
    SEAM(0);
    for (int l = 0; l < DEPTH; ++l) {
        const int pb = 1 + 7 * l; const bool even = (l & 1) == 0; const int li = l >> 1;
        bf16_t* Zl = even ? Zev : Zod;
        if (IN(pb)) for (int rep = 0; rep < (PROBE_DUP == 5 ? 2 : 1); ++rep) {
            const int N = even ? EVEN_IN : ODD_IN;
            const bf16_t* Wt = even ? (const bf16_t*)(ws + WS_WIN_EVEN) + (size_t)li * DM * EVEN_IN : (const bf16_t*)(ws + WS_WIN_ODD) + (size_t)li * DM * ODD_IN;
            pg8::Gemm g{XB, Wt, M_TOK, N, DM}; pg8::StaticOrder S; S.init(M_TOK, N, G, bid);
            pg8::EpiScaleBf16<0> E{Zl, N, rowsq + (size_t)(2 * l) * M_TOK * 16};
#if !defined(NO_GEMM) && !defined(NO_G1)
            pg8::gemm_phase<pg8::EpiScaleBf16<0>, pg8::StaticOrder, true, true>((LAS unsigned char*)lds, g, S, E);
#endif
        }
        SEAM(pb);
        if (IN(pb + 1)) {
            if (even) {
                if (G == 256) hgrn_s1(lds, (bid & 7) * 256 + (bid >> 3), 32, (bid & 7) * 256 + 256, Zl, ws, (unsigned char*)a.out, a.in[8], li);
                else hgrn_s1(lds, bid, G, 2048, Zl, ws, (unsigned char*)a.out, a.in[8], li);
                for (int it = (G == 256 ? ((bid & 7) * 32 + (bid >> 3)) : bid); it < 256; it += G)
                    rglru_item(lds, it >> 5, (it >> 2) & 7, it & 3, Zl, Y, a.in[10] + li * 2048, a.in[11] + li * 512, a.in[12] + (size_t)li * 32768, a.in[13] + li * 512,
                               a.in[14] + (size_t)li * 32768, a.in[15] + li * 512, a.in[16] + li * 512);
            } else {
                for (int it = (G == 256 ? ((bid & 7) * 128 + (bid >> 3)) : bid); it < (G == 256 ? (bid & 7) * 128 + 128 : 1024); it += (G == 256 ? 32 : G))
                    swa_item(lds, it >> 7, (it >> 2) & 31, it & 3, Zl, Y, cosT, sinT, a.in[19] + li * 64, a.in[20] + li * 64, a.in[21] + li * 16);
            }
        }
        if (even) SEAM(pb + 1);
        if (IN(pb + 2) && even) { for (int blk = (G == 256 ? ((bid & 7) * 16 + (bid >> 3)) : bid); blk < 128 && (G != 256 || bid < 128); blk += G) hgrn_s2(lds, blk, ws, (const unsigned char*)a.out, Y); }
        if (even) SEAM(pb + 2);
        if (IN(pb + 3) && even) hgrn_s3(G, bid, Zl, Y, a.in[9] + li * 512);
        SEAM(pb + 3);
        if (IN(pb + 4)) {
            const bf16_t* Wt = even ? (const bf16_t*)(ws + WS_WOUT_EVEN) + (size_t)li * DM * DM : (const bf16_t*)(ws + WS_WOUT_ODD) + (size_t)li * DM * DM;
            pg8::Gemm g{Y, Wt, M_TOK, DM, DM}; pg8::StaticOrder S; S.init(M_TOK, DM, G, bid);
            pg8::EpiResid E{XB, XLO, nullptr, rowsq + (size_t)(2 * l + 1) * M_TOK * 16, DM};
#if !defined(NO_GEMM) && !defined(NO_G2)
            pg8::gemm_phase<pg8::EpiResid, pg8::StaticOrder, true, true>((LAS unsigned char*)lds, g, S, E);
#endif
        }
        SEAM(pb + 4);
        if (IN(pb + 5)) for (int rep = 0; rep < (PROBE_DUP == 3 ? 2 : 1); ++rep) {
            pg8::Gemm g{XB, (const bf16_t*)(ws + WS_WMLP_IN) + (size_t)l * DM * DFF, M_TOK, DFF, DM}; pg8::StaticOrder S; S.init(M_TOK, DFF, G, bid);
            pg8::EpiScaleBf16<1> E{HID, DFF, rowsq + (size_t)(2 * l + 1) * M_TOK * 16};
#if !defined(NO_GEMM) && !defined(NO_G3)
            pg8::gemm_phase<pg8::EpiScaleBf16<1>, pg8::StaticOrder, true, true>((LAS unsigned char*)lds, g, S, E);
#endif
        }
        SEAM(pb + 5);
        if (IN(pb + 6)) {
            pg8::Gemm g{HID, (const bf16_t*)(ws + WS_WMLP_OUT) + (size_t)l * DM * DFF, M_TOK, DM, DFF}; pg8::StaticOrder S; S.init(M_TOK, DM, G, bid);
            pg8::EpiResid E{XB, XLO, (l + 1 < DEPTH) ? nullptr : a.out, (l + 1 < DEPTH) ? rowsq + (size_t)(2 * l + 2) * M_TOK * 16 : nullptr, DM};
#if !defined(NO_GEMM) && !defined(NO_G4)
            pg8::gemm_phase<pg8::EpiResid, pg8::StaticOrder, true, true>((LAS unsigned char*)lds, g, S, E);
#endif
        }
        SEAM(pb + 6);
    }
#undef IN
#undef SEAM
}

extern "C" void kernel_launch(void* const* d_in, const int* in_sizes, int n_in, void* d_out, int out_size, void* d_ws, size_t ws_size, hipStream_t stream) {
    static int grid = 0;
    if (grid == 0) {
        if (n_in != 22 || out_size != M_TOK * DM || ws_size < WS_END) { fprintf(stderr, "kernel_launch: unexpected shapes (n_in %d out %d ws %zu)\n", n_in, out_size, ws_size); grid = -1; return; }
        int dev = 0, cus = 0, per_cu = 0;
        (void)hipGetDevice(&dev); (void)hipDeviceGetAttribute(&cus, hipDeviceAttributeMultiprocessorCount, dev);
        if (hipFuncSetAttribute((const void*)trunk_fwd, hipFuncAttributeMaxDynamicSharedMemorySize, LDS_BYTES) != hipSuccess) { fprintf(stderr, "kernel_launch: hipFuncSetAttribute failed\n"); grid = -1; return; }
        if (hipOccupancyMaxActiveBlocksPerMultiprocessor(&per_cu, (const void*)trunk_fwd, NTHREADS, LDS_BYTES) != hipSuccess || per_cu < 1) { fprintf(stderr, "kernel_launch: occupancy query says %d\n", per_cu); per_cu = 1; }
        (void)hipGetLastError();
        grid = cus;
    }
    if (grid < 0) return;
    (void)hipMemsetAsync((char*)d_ws + WS_BAR, 0, 2 * XCD_BAR_WORDS * 4, stream);
    Args a{};
    for (int i = 0; i < 22; ++i) a.in[i] = (const float*)d_in[i];
    a.pos = (const int*)d_in[1]; a.out = (float*)d_out; a.ws = (unsigned char*)d_ws;
#if MK_MULTI
    for (int ph = 0; ph < N_PHASES; ++ph) { a.ph_lo = ph; a.ph_hi = ph + 1; hipLaunchKernelGGL(trunk_fwd, dim3(grid), dim3(NTHREADS), LDS_BYTES, stream, a); }
#else
    a.ph_lo = 0; a.ph_hi = N_PHASES;
    void* args[] = {&a};
    hipError_t e = hipLaunchCooperativeKernel((const void*)trunk_fwd, dim3(grid), dim3(NTHREADS), args, LDS_BYTES, stream);
    if (e != hipSuccess) fprintf(stderr, "cooperative launch failed: %s (grid %d)\n", hipGetErrorString(e), grid);
#endif
}
```
